# Optimizing an MI355X kernel written in HIP

```python
import math
import jax, jax.numpy as jnp
from jax import lax
import numpy as np

D_MODEL = 1024
BATCH = 4
SEQ = 8192
DEPTH = 4
DEC_BATCH = 1
DEC_SEQ = 16384
PAST_LEN = 128

N_EVEN = (DEPTH + 1) // 2
N_ODD = DEPTH // 2
EPS = 1e-6
F32 = jnp.float32

S5_WIDTH = D_MODEL // 2
S5_GROUP = 16
S5_GROUPS = S5_WIDTH // S5_GROUP
S5_STATE = 64
DT_MIN = 1e-3
DT_MAX = 1e-1

RW_WIDTH = D_MODEL // 2
RW_HEAD = 64
RW_HEADS = RW_WIDTH // RW_HEAD
RW_LORA_W = 64
RW_LORA_A = 64
RW_LN_EPS = 64e-5
RW_SHIFTED = 3 * RW_WIDTH + RW_LORA_W + RW_LORA_A

EVEN_IN = 2 * S5_WIDTH + RW_SHIFTED + RW_WIDTH
EVEN_MIX = S5_WIDTH + RW_WIDTH

AT_HEADS = 16
AT_KV_HEADS = 4
AT_GROUP = AT_HEADS // AT_KV_HEADS
AT_HEAD_DIM = D_MODEL // AT_HEADS
AT_WINDOW = 128
AT_BLOCK = 128
AT_WIDTH = AT_HEADS * AT_HEAD_DIM
AT_KV_WIDTH = AT_KV_HEADS * AT_HEAD_DIM
ODD_IN = 2 * AT_WIDTH + 2 * AT_KV_WIDTH
NEG_INF = -1e30

kernel_name = "hybrid_s5_rwkv7_swa_encoder"


def rms_norm(x, g):
    xf = x.astype(F32)
    y = xf * lax.rsqrt(jnp.mean(xf * xf, axis=-1, keepdims=True) + EPS)
    return (y * g.astype(F32)).astype(x.dtype)


def _complex_affine_op(c1, c2):
    a1r, a1i, b1r, b1i = c1
    a2r, a2i, b2r, b2i = c2
    return (a2r * a1r - a2i * a1i,
            a2r * a1i + a2i * a1r,
            a2r * b1r - a2i * b1i + b2r,
            a2r * b1i + a2i * b1r + b2i)


def s5_direction(u, a_re, a_im, log_dt, b_re, b_im, c_re, c_im, reverse):
    dt = jnp.exp(log_dt.astype(F32))[:, None]
    ar = a_re.astype(F32)
    ai = a_im.astype(F32)
    mag = jnp.exp(ar * dt)
    lr = mag * jnp.cos(ai * dt)
    li = mag * jnp.sin(ai * dt)
    den = ar * ar + ai * ai
    nr = lr - 1.0
    qr = (nr * ar + li * ai) / den
    qi = (li * ar - nr * ai) / den
    br = b_re.astype(F32)
    bi = b_im.astype(F32)
    bbr = qr[..., None] * br - qi[..., None] * bi
    bbi = qr[..., None] * bi + qi[..., None] * br
    hr = jnp.einsum('blgc,gnc->blgn', u, bbr)
    hi = jnp.einsum('blgc,gnc->blgn', u, bbi)
    shp = hr.shape
    _, _, hr, hi = lax.associative_scan(
        _complex_affine_op,
        (jnp.broadcast_to(lr, shp), jnp.broadcast_to(li, shp), hr, hi),
        reverse=reverse, axis=1)
    return (jnp.einsum('blgn,gcn->blgc', hr, c_re.astype(F32))
            - jnp.einsum('blgn,gcn->blgc', hi, c_im.astype(F32)))


def s5_branch(u, z, p):
    B, L, _ = u.shape
    uf = u.astype(F32)
    ug = uf.reshape(B, L, S5_GROUPS, S5_GROUP)
    y = (s5_direction(ug, p['s5_a_re'][0], p['s5_a_im'][0], p['s5_log_dt'][0],
                      p['s5_b_re'][0], p['s5_b_im'][0], p['s5_c_re'][0], p['s5_c_im'][0], False)
         + s5_direction(ug, p['s5_a_re'][1], p['s5_a_im'][1], p['s5_log_dt'][1],
                        p['s5_b_re'][1], p['s5_b_im'][1], p['s5_c_re'][1], p['s5_c_im'][1], True))
    y = y.reshape(B, L, S5_WIDTH) + p['s5_d'].astype(F32) * uf
    y = jax.nn.gelu(y)
    y = y * jax.nn.sigmoid(y @ p['s5_glu_w'].astype(F32) + p['s5_glu_b'].astype(F32))
    return y * jax.nn.silu(z.astype(F32))


def centred_shift(x, mu):
    xp = jnp.pad(x, ((0, 0), (1, 1), (0, 0)))
    nb = 0.5 * (xp[:, :-2] + xp[:, 2:])
    return x + mu * (nb - x)


def rwkv_scan(r, w, k, v, kk, b, reverse):
    Bsz, H, N = r.shape[1:]

    def step(S, inp):
        r_t, w_t, k_t, v_t, kk_t, b_t = inp
        sa = -jnp.einsum('bhvk,bhk->bhv', S, kk_t)
        S = (S * w_t[:, :, None, :] + sa[..., None] * b_t[:, :, None, :]
             + v_t[..., None] * k_t[:, :, None, :])
        return S, jnp.einsum('bhvk,bhk->bhv', S, r_t)

    S0 = jnp.zeros((Bsz, H, N, N), F32)
    _, y = lax.scan(step, S0, (r, w, k, v, kk, b), reverse=reverse)
    return y


def rwkv_branch(h, z, p):
    B, L, _ = h.shape
    h = centred_shift(h.astype(F32), p['rw_mu'].astype(F32))
    r, k, v, lw, la = jnp.split(h, [RW_WIDTH, 2 * RW_WIDTH, 3 * RW_WIDTH,
                                    3 * RW_WIDTH + RW_LORA_W], axis=-1)
    a = jax.nn.sigmoid(p['rw_a0'].astype(F32) + la @ p['rw_a_up'].astype(F32))
    tw = jnp.tanh(lw)

    def decay(d):
        wl = -jax.nn.softplus(-(p['rw_w0'][d].astype(F32) + tw @ p['rw_w_up'][d].astype(F32))) - 0.5
        return jnp.exp(-jnp.exp(wl))

    heads = lambda t: t.reshape(B, L, RW_HEADS, RW_HEAD)
    kk = heads(k * p['rw_k_k'].astype(F32))
    kk = kk / jnp.maximum(jnp.sqrt(jnp.sum(kk * kk, axis=-1, keepdims=True)), 1e-12)
    k = k * (1.0 + (a - 1.0) * p['rw_k_a'].astype(F32))
    rh, kh, vh, ah = heads(r), heads(k), heads(v), heads(a)
    tm = lambda t: jnp.swapaxes(t, 0, 1)
    R, K, V, KK, BB = tm(rh), tm(kh), tm(vh), tm(kk), tm(kk * ah)
    y = (rwkv_scan(R, tm(heads(decay(0))), K, V, KK, BB, False)
         + rwkv_scan(R, tm(heads(decay(1))), K, V, KK, BB, True))
    y = tm(y)
    mean = jnp.mean(y, axis=-1, keepdims=True)
    var = jnp.mean(jnp.square(y - mean), axis=-1, keepdims=True)
    y = ((y - mean) * lax.rsqrt(var + RW_LN_EPS)).reshape(B, L, RW_WIDTH)
    y = y * p['rw_ln_g'].astype(F32) + p['rw_ln_b'].astype(F32)
    bonus = jnp.sum(rh * kh * p['rw_r_k'].astype(F32), axis=-1, keepdims=True) * vh
    y = y + bonus.reshape(B, L, RW_WIDTH)
    return y * jax.nn.silu(z.astype(F32))


def alibi_slopes():
    return jnp.exp2(-8.0 * jnp.arange(1, AT_HEADS + 1, dtype=F32) / AT_HEADS)


def rms_head(t, g):
    tf = t.astype(F32)
    return tf * lax.rsqrt(jnp.mean(tf * tf, axis=-1, keepdims=True) + EPS) * g.astype(F32)


def attn_branch(h, p):
    B, L, _ = h.shape
    q, k, v, z = jnp.split(h, [AT_WIDTH, AT_WIDTH + AT_KV_WIDTH,
                               AT_WIDTH + 2 * AT_KV_WIDTH], axis=-1)
    q = rms_head(q.reshape(B, L, AT_HEADS, AT_HEAD_DIM), p['at_q_norm']) * (AT_HEAD_DIM ** -0.5)
    k = rms_head(k.reshape(B, L, AT_KV_HEADS, AT_HEAD_DIM), p['at_k_norm'])
    v = v.reshape(B, L, AT_KV_HEADS, AT_HEAD_DIM).astype(F32)
    nb = L // AT_BLOCK
    qb = q.reshape(B, nb, AT_BLOCK, AT_KV_HEADS, AT_GROUP, AT_HEAD_DIM).transpose(1, 0, 2, 3, 4, 5)

    def band(t):
        tp = jnp.pad(t, ((0, 0), (AT_BLOCK, AT_BLOCK), (0, 0), (0, 0)))
        tp = tp.reshape(B, nb + 2, AT_BLOCK, AT_KV_HEADS, AT_HEAD_DIM)
        w = jnp.concatenate([tp[:, :-2], tp[:, 1:-1], tp[:, 2:]], axis=2)
        return jnp.swapaxes(w, 0, 1)

    kb, vb = band(k), band(v)
    rel = AT_BLOCK + jnp.arange(AT_BLOCK)[:, None] - jnp.arange(3 * AT_BLOCK)[None, :]
    in_win = jnp.abs(rel) <= AT_WINDOW
    slopes = alibi_slopes().reshape(AT_KV_HEADS, AT_GROUP)
    bias = -slopes[:, :, None, None] * jnp.abs(rel).astype(F32)
    sink = p['at_sink'].astype(F32).reshape(1, AT_KV_HEADS, AT_GROUP, 1)

    def block(args):
        i, qi, ki, vi = args
        s_pos = (i - 1) * AT_BLOCK + jnp.arange(3 * AT_BLOCK)
        valid = in_win & ((s_pos >= 0) & (s_pos < L))[None, :]
        s = jnp.einsum('bqkgd,bskd->bkgqs', qi, ki) + bias
        s = jnp.where(valid, s, NEG_INF)
        m = jnp.maximum(jnp.max(s, axis=-1), sink)
        pr = jnp.exp(s - m[..., None])
        den = jnp.sum(pr, axis=-1) + jnp.exp(sink - m)
        o = jnp.einsum('bkgqs,bskd->bqkgd', pr, vi)
        return o / jnp.transpose(den, (0, 3, 1, 2))[..., None]

    o = lax.map(block, (jnp.arange(nb), qb, kb, vb))
    o = o.transpose(1, 0, 2, 3, 4, 5).reshape(B, L, AT_WIDTH)
    return o * jax.nn.silu(z.astype(F32))


def even_layer(x, p):
    h = rms_norm(x, p['norm'])
    proj = h @ p['w_in']
    u, z_s5, h_rw, z_rw = jnp.split(
        proj, [S5_WIDTH, 2 * S5_WIDTH, 2 * S5_WIDTH + RW_SHIFTED], axis=-1)
    ya = s5_branch(u, z_s5, p)
    yb = rwkv_branch(h_rw, z_rw, p)
    y = jnp.concatenate([ya, yb], axis=-1).astype(x.dtype) @ p['w_out']
    return x + y.astype(x.dtype)


def odd_layer(x, p):
    h = rms_norm(x, p['norm'])
    o = attn_branch(h @ p['w_in'], p)
    return x + (o.astype(x.dtype) @ p['w_out']).astype(x.dtype)


def setup_inputs(seed: int = 0) -> dict:
    key = jax.random.key(seed)
    ks = iter(jax.random.split(key, 40))
    nrm = lambda shape, scale: scale * jax.random.normal(next(ks), shape, F32)
    NE, NO, G, N = N_EVEN, N_ODD, S5_GROUPS, S5_STATE
    a_im_base = jnp.pi * jnp.arange(N, dtype=F32)
    return {
        'x_prompt': nrm((BATCH, SEQ, D_MODEL), 1.0),
        'x_sample': nrm((DEC_BATCH, DEC_SEQ, D_MODEL), 1.0),
        'ev_norm': 1.0 + nrm((NE, D_MODEL), 0.02),
        'ev_w_in': nrm((NE, D_MODEL, EVEN_IN), D_MODEL ** -0.5),
        's5_a_re': -0.5 + nrm((NE, 2, G, N), 0.01),
        's5_a_im': a_im_base + nrm((NE, 2, G, N), 0.01),
        's5_log_dt': jax.random.uniform(next(ks), (NE, 2, G), F32,
                                        math.log(DT_MIN), math.log(DT_MAX)),
        's5_b_re': nrm((NE, 2, G, N, S5_GROUP), (2 * S5_GROUP) ** -0.5),
        's5_b_im': nrm((NE, 2, G, N, S5_GROUP), (2 * S5_GROUP) ** -0.5),
        's5_c_re': nrm((NE, 2, G, S5_GROUP, N), (2 * N) ** -0.5),
        's5_c_im': nrm((NE, 2, G, S5_GROUP, N), (2 * N) ** -0.5),
        's5_d': nrm((NE, S5_WIDTH), 1.0),
        's5_glu_w': nrm((NE, S5_WIDTH, S5_WIDTH), S5_WIDTH ** -0.5),
        's5_glu_b': nrm((NE, S5_WIDTH), 0.01),
        'rw_mu': jax.random.uniform(next(ks), (NE, RW_SHIFTED), F32),
        'rw_w0': jax.random.uniform(next(ks), (NE, 2, RW_WIDTH), F32, -6.0, -1.0),
        'rw_w_up': nrm((NE, 2, RW_LORA_W, RW_WIDTH), 0.05),
        'rw_a0': nrm((NE, RW_WIDTH), 0.1),
        'rw_a_up': nrm((NE, RW_LORA_A, RW_WIDTH), 0.05),
        'rw_k_k': 0.85 + nrm((NE, RW_WIDTH), 0.02),
        'rw_k_a': 1.0 + nrm((NE, RW_WIDTH), 0.02),
        'rw_r_k': nrm((NE, RW_HEADS, RW_HEAD), 0.1),
        'rw_ln_g': 1.0 + nrm((NE, RW_WIDTH), 0.02),
        'rw_ln_b': nrm((NE, RW_WIDTH), 0.01),
        'ev_w_out': nrm((NE, EVEN_MIX, D_MODEL), EVEN_MIX ** -0.5),
        'od_norm': 1.0 + nrm((NO, D_MODEL), 0.02),
        'od_w_in': nrm((NO, D_MODEL, ODD_IN), D_MODEL ** -0.5),
        'at_q_norm': 1.0 + nrm((NO, AT_HEAD_DIM), 0.02),
        'at_k_norm': 1.0 + nrm((NO, AT_HEAD_DIM), 0.02),
        'at_sink': nrm((NO, AT_HEADS), 1.0),
        'od_w_out': nrm((NO, AT_WIDTH, D_MODEL), AT_WIDTH ** -0.5),
    }


def reference(x_prompt, x_sample, ev_norm, ev_w_in, s5_a_re, s5_a_im, s5_log_dt,
              s5_b_re, s5_b_im, s5_c_re, s5_c_im, s5_d, s5_glu_w, s5_glu_b,
              rw_mu, rw_w0, rw_w_up, rw_a0, rw_a_up, rw_k_k, rw_k_a, rw_r_k,
              rw_ln_g, rw_ln_b, ev_w_out, od_norm, od_w_in, at_q_norm, at_k_norm,
              at_sink, od_w_out):
    ev = {'norm': ev_norm, 'w_in': ev_w_in, 's5_a_re': s5_a_re, 's5_a_im': s5_a_im,
          's5_log_dt': s5_log_dt, 's5_b_re': s5_b_re, 's5_b_im': s5_b_im,
          's5_c_re': s5_c_re, 's5_c_im': s5_c_im, 's5_d': s5_d, 's5_glu_w': s5_glu_w,
          's5_glu_b': s5_glu_b, 'rw_mu': rw_mu, 'rw_w0': rw_w0, 'rw_w_up': rw_w_up,
          'rw_a0': rw_a0, 'rw_a_up': rw_a_up, 'rw_k_k': rw_k_k, 'rw_k_a': rw_k_a,
          'rw_r_k': rw_r_k, 'rw_ln_g': rw_ln_g, 'rw_ln_b': rw_ln_b, 'w_out': ev_w_out}
    od = {'norm': od_norm, 'w_in': od_w_in, 'at_q_norm': at_q_norm,
          'at_k_norm': at_k_norm, 'at_sink': at_sink, 'w_out': od_w_out}

    def trunk(x):
        for layer in range(DEPTH):
            j = layer // 2
            if layer % 2 == 0:
                x = even_layer(x, {n: a[j] for n, a in ev.items()})
            else:
                x = odd_layer(x, {n: a[j] for n, a in od.items()})
        return x

    y_prompt = trunk(x_prompt)
    y_sample = trunk(x_sample)
    return (y_prompt, y_sample)
```

```cpp
#include <hip/hip_runtime.h>
#include <cstdio>
#include <cstdint>

#define GAS __attribute__((address_space(1)))
#define LAS __attribute__((address_space(3)))
typedef unsigned short bf16_t;
typedef short bf16x8 __attribute__((ext_vector_type(8)));
typedef float f32x4 __attribute__((ext_vector_type(4)));
typedef float f32x2 __attribute__((ext_vector_type(2)));
typedef float f32x16 __attribute__((ext_vector_type(16)));
typedef unsigned u32x4 __attribute__((ext_vector_type(4)));
typedef unsigned u32x2 __attribute__((ext_vector_type(2)));
typedef __bf16 bf16x2_t __attribute__((ext_vector_type(2)));
typedef GAS unsigned gu32;
typedef short v4i16_t __attribute__((ext_vector_type(4)));

constexpr int T = 49152;
constexpr int TP = 32768;
constexpr int DM = 1024;
constexpr int NINST = T / 16;
constexpr int EV_N = 3328;
constexpr int PRW_LD = 2304;
constexpr int OD_N = 2560;

constexpr size_t MiB = 1u << 20;
constexpr size_t WS_CTL = 0, CTL_ZERO_BYTES = 1 * MiB;
constexpr size_t WS_WIN = 1 * MiB;
constexpr size_t WS_WOUT = 8 * MiB;
constexpr size_t WS_WGLU = 10 * MiB;
constexpr size_t WS_BMAT = 11 * MiB;
constexpr size_t WS_W2 = 15 * MiB;
constexpr size_t WS_A = 24 * MiB;
constexpr size_t WS_UH = 120 * MiB;
constexpr size_t WS_ZS5 = 216 * MiB;
constexpr size_t WS_PRW = 264 * MiB;
constexpr size_t WS_LORA = 23 * MiB;
constexpr size_t WS_RWH = 480 * MiB;
constexpr size_t WS_END = 504 * MiB;

constexpr int CW_BAR = 4096;

__device__ __forceinline__ unsigned f2bf(float f) { unsigned u = __builtin_bit_cast(unsigned, f); return (u + 0x7fffu + ((u >> 16) & 1u)) >> 16; }
__device__ __forceinline__ unsigned pk2(float lo, float hi) { f32x2 v = {lo, hi}; bf16x2_t b = __builtin_convertvector(v, bf16x2_t); return __builtin_bit_cast(unsigned, b); }
__device__ __forceinline__ float bf2f(unsigned short u) { return __builtin_bit_cast(float, (unsigned)u << 16); }
__device__ __forceinline__ float bflo(unsigned u) { return __builtin_bit_cast(float, u << 16); }
__device__ __forceinline__ float bfhi(unsigned u) { return __builtin_bit_cast(float, u & 0xffff0000u); }
__device__ __forceinline__ float sigmoidf_(float v) { return __builtin_amdgcn_rcpf(1.0f + __expf(-v)); }
__device__ __forceinline__ float siluf_(float v) { return v * sigmoidf_(v); }
__device__ __forceinline__ float gelu_tanh(float x) { const float u = 0.7978845608028654f * (x + 0.044715f * x * x * x); return x * sigmoidf_(2.0f * u); }
template <int CTRL> __device__ __forceinline__ float dpp_f(float x) { return __builtin_bit_cast(float, __builtin_amdgcn_update_dpp(0, __builtin_bit_cast(int, x), CTRL, 0xf, 0xf, true)); }
__device__ __forceinline__ float wave_sum_fast(float x) {
    x += dpp_f<0xB1>(x); x += dpp_f<0x4E>(x); x += dpp_f<0x141>(x); x += dpp_f<0x140>(x);
    return (__builtin_bit_cast(float, __builtin_amdgcn_readlane(__builtin_bit_cast(int, x), 0)) + __builtin_bit_cast(float, __builtin_amdgcn_readlane(__builtin_bit_cast(int, x), 16)))
         + (__builtin_bit_cast(float, __builtin_amdgcn_readlane(__builtin_bit_cast(int, x), 32)) + __builtin_bit_cast(float, __builtin_amdgcn_readlane(__builtin_bit_cast(int, x), 48)));
}
__device__ __forceinline__ float reduce8(float x) { x += dpp_f<0xB1>(x); x += dpp_f<0x4E>(x); x += dpp_f<0x141>(x); return x; }
__device__ __forceinline__ void unpack8(const u32x4 w, float (&f)[8]) {
    f[0] = bflo(w.x); f[1] = bfhi(w.x); f[2] = bflo(w.y); f[3] = bfhi(w.y); f[4] = bflo(w.z); f[5] = bfhi(w.z); f[6] = bflo(w.w); f[7] = bfhi(w.w);
}
__device__ __forceinline__ u32x4 pack8(const float (&f)[8]) { u32x4 w; w.x = pk2(f[0], f[1]); w.y = pk2(f[2], f[3]); w.z = pk2(f[4], f[5]); w.w = pk2(f[6], f[7]); return w; }

namespace pg8 {
constexpr int BM = 256, BK = 64, HALF = 128, HTB = HALF * BK * 2, STAGE_BYTES = 8 * HTB, NXCD = 8, WGM = 8;
__host__ __device__ __forceinline__ int lds_byte(int r, int c) { const int st = (r >> 4) * 2 + (c >> 5), rr = r & 15, cc = c & 31, ob = rr * 64 + cc * 2; return st * 1024 + (ob ^ (((ob >> 9) & 1) << 5)); }
__host__ __device__ __forceinline__ void stage_rc(int b, int& R, int& C) { const int st = b / 1024, sb = b % 1024, swz = sb ^ (((sb >> 9) & 1) << 5); R = (st >> 1) * 16 + swz / 64; C = (st & 1) * 32 + (swz % 64) / 2; }
__host__ __device__ __forceinline__ int perm32(int rho) { const int n = rho >> 4, i = rho & 15; return 8 * (i >> 2) + 4 * n + (i & 3); }

struct Unit { int pm, pn, pb; };
struct Gemm { const bf16_t* A; const bf16_t* Bt; int K, lda, ldb; };

struct StaticOrder {
    int nM, nN, nwg, G, c;
    __device__ void init(int M, int N, int G_, int c_) { nM = M / BM; nN = N / BM; nwg = nM * nN; G = G_; c = c_; }
    __device__ bool next(int i, Unit& u) const {
        const long L = (long)i * G + c; if (L >= nwg) return false;
        int wgid = (int)L; { const int q = nwg / NXCD, r = nwg % NXCD, xcd = wgid % NXCD, off = wgid / NXCD; wgid = (xcd < r ? xcd * (q + 1) : r * (q + 1) + (xcd - r) * q) + off; }
        const int nig = WGM * nN, gid = wgid / nig, fm = gid * WGM, gsz = (nM - fm) < WGM ? (nM - fm) : WGM;
        u.pm = fm + ((wgid % nig) % gsz); u.pn = (wgid % nig) / gsz; u.pb = u.pn; return true;
    }
};
struct SpanOrder : StaticOrder {
    int base, stride, cnt;
    __device__ bool next(int i, Unit& u) const { if (i >= cnt) return false; StaticOrder t = *this; t.G = 1; t.c = base + i * stride; return t.StaticOrder::next(0, u); }
};
struct GroupedOrder {
    int nM, per, G, c;
    __device__ void init(int nM_, int per_, int G_, int c_) { nM = nM_; per = per_; G = G_; c = c_; }
    __device__ bool next(int i, Unit& u) const { const int L = i * G + c; if (L >= nM) return false; u.pm = L; u.pn = 0; u.pb = L / per; return true; }
};

template <class T> __device__ __forceinline__ void acc_zero(T& acc) {
#pragma unroll
    for (int a = 0; a < 2; ++a)
#pragma unroll
        for (int b = 0; b < 2; ++b)
#pragma unroll
            for (int m = 0; m < 4; ++m)
#pragma unroll
                for (int n = 0; n < 2; ++n) acc[a][b][m][n] = (f32x4){0.f, 0.f, 0.f, 0.f}; }
struct EpiBf16 {
    static constexpr bool PERM = true;
    bf16_t* O; int ldc;
    __device__ __forceinline__ void init(f32x4 (&acc)[2][2][4][2], const Unit&, int, int, int, int) const { acc_zero(acc); }
    __device__ __forceinline__ void operator()(const f32x4 (&acc)[2][2][4][2], const Unit& u, int wr, int wc, int fr, int fq) const {
        const int row0 = u.pm * BM + wr * 64 + fr, col0 = u.pn * BM + wc * 32 + 8 * fq;
#pragma unroll
        for (int ai = 0; ai < 2; ++ai)
#pragma unroll
            for (int m = 0; m < 4; ++m) { bf16_t* rowp = O + (size_t)(row0 + ai * HALF + m * 16) * ldc + col0;
#pragma unroll
                for (int bj = 0; bj < 2; ++bj) { const f32x4 v0 = acc[ai][bj][m][0], v1 = acc[ai][bj][m][1];
                    u32x4 w; w.x = pk2(v0[0], v0[1]); w.y = pk2(v0[2], v0[3]); w.z = pk2(v1[0], v1[1]); w.w = pk2(v1[2], v1[3]);
                    *(u32x4*)(rowp + bj * HALF) = w; } }
    }
};
struct EpiEvenIn {
    static constexpr bool PERM = true;
    bf16_t* UH; bf16_t* ZS5; bf16_t* PRW;
    __device__ __forceinline__ void init(f32x4 (&acc)[2][2][4][2], const Unit&, int, int, int, int) const { acc_zero(acc); }
    __device__ __forceinline__ void operator()(const f32x4 (&acc)[2][2][4][2], const Unit& u, int wr, int wc, int fr, int fq) const {
        const int row0 = u.pm * BM + wr * 64 + fr, col0 = u.pn * BM + wc * 32 + 8 * fq;
#pragma unroll
        for (int ai = 0; ai < 2; ++ai)
#pragma unroll
            for (int m = 0; m < 4; ++m) { const int row = row0 + ai * HALF + m * 16;
#pragma unroll
                for (int bj = 0; bj < 2; ++bj) { const f32x4 v0 = acc[ai][bj][m][0], v1 = acc[ai][bj][m][1]; const int col = col0 + bj * HALF;
                    u32x4 w; w.x = pk2(v0[0], v0[1]); w.y = pk2(v0[2], v0[3]); w.z = pk2(v1[0], v1[1]); w.w = pk2(v1[2], v1[3]);
                    bf16_t* p;
                    if (u.pn < 2) p = UH + ((size_t)((col >> 4) * NINST + (row >> 4)) * 512 + (row & 15) * 16 + (col & 15));
                    else if (u.pn < 4) p = ZS5 + (size_t)row * 512 + (col - 512);
                    else p = PRW + (size_t)row * PRW_LD + (col - 1024);
                    *(u32x4*)p = w; } }
    }
};
struct EpiS5Out {
    static constexpr bool PERM = true;
    bf16_t* YG;
    __device__ __forceinline__ void init(f32x4 (&acc)[2][2][4][2], const Unit&, int, int, int, int) const { acc_zero(acc); }
    __device__ __forceinline__ void operator()(const f32x4 (&acc)[2][2][4][2], const Unit& u, int wr, int wc, int fr, int fq) const {
        const int row0 = u.pm * BM + wr * 64 + fr, col0 = wc * 32 + 8 * fq;
#pragma unroll
        for (int ai = 0; ai < 2; ++ai)
#pragma unroll
            for (int m = 0; m < 4; ++m) { const int row = row0 + ai * HALF + m * 16; const int g = row / NINST, inst = row - g * NINST;
#pragma unroll
                for (int bj = 0; bj < 2; ++bj) { const f32x4 v0 = acc[ai][bj][m][0], v1 = acc[ai][bj][m][1]; const int col = col0 + bj * HALF;
                    u32x4 w; w.x = pk2(gelu_tanh(v0[0]), gelu_tanh(v0[1])); w.y = pk2(gelu_tanh(v0[2]), gelu_tanh(v0[3])); w.z = pk2(gelu_tanh(v1[0]), gelu_tanh(v1[1])); w.w = pk2(gelu_tanh(v1[2]), gelu_tanh(v1[3]));
                    *(u32x4*)(YG + (size_t)(inst * 16 + (col >> 4)) * 512 + g * 16 + (col & 15)) = w; } }
    }
};
struct EpiGlu {
    static constexpr bool PERM = true;
    const bf16_t* YG; const bf16_t* ZS5; const float* bias; bf16_t* MIX;
    __device__ __forceinline__ void init(f32x4 (&acc)[2][2][4][2], const Unit&, int, int, int, int) const { acc_zero(acc); }
    __device__ __forceinline__ void operator()(const f32x4 (&acc)[2][2][4][2], const Unit& u, int wr, int wc, int fr, int fq) const {
        const int row0 = u.pm * BM + wr * 64 + fr, col0 = u.pn * BM + wc * 32 + 8 * fq;
#pragma unroll
        for (int bj = 0; bj < 2; ++bj) { const int col = col0 + bj * HALF;
            const f32x4 b0 = *(const f32x4*)(bias + col), b1 = *(const f32x4*)(bias + col + 4);
#pragma unroll
            for (int ai = 0; ai < 2; ++ai)
#pragma unroll
                for (int m = 0; m < 4; ++m) { const int row = row0 + ai * HALF + m * 16;
                    const f32x4 v0 = acc[ai][bj][m][0] + b0, v1 = acc[ai][bj][m][1] + b1;
                    float yg[8], z[8], o[8]; unpack8(*(const u32x4*)(YG + (size_t)row * 512 + col), yg); unpack8(*(const u32x4*)(ZS5 + (size_t)row * 512 + col), z);
#pragma unroll
                    for (int i = 0; i < 4; ++i) { o[i] = yg[i] * sigmoidf_(v0[i]) * siluf_(z[i]); o[4 + i] = yg[4 + i] * sigmoidf_(v1[i]) * siluf_(z[4 + i]); }
                    *(u32x4*)(MIX + (size_t)row * 1024 + col) = pack8(o); } }
    }
};
struct EpiRes {
    static constexpr bool PERM = false;
    const float* b0; const float* b1; float* out;
    __device__ __forceinline__ void init(f32x4 (&acc)[2][2][4][2], const Unit& u, int wr, int wc, int fr, int fq) const {
        const int row0 = u.pm * BM + wr * 64 + fr, col0 = u.pn * BM + wc * 32 + 4 * fq;
#pragma unroll
        for (int ai = 0; ai < 2; ++ai)
#pragma unroll
            for (int m = 0; m < 4; ++m) { const int row = row0 + ai * HALF + m * 16; const float* bp = (row < TP ? b0 + (size_t)row * DM : b1 + (size_t)(row - TP) * DM) + col0;
#pragma unroll
                for (int bj = 0; bj < 2; ++bj)
#pragma unroll
                    for (int n = 0; n < 2; ++n) acc[ai][bj][m][n] = *(const f32x4*)(bp + bj * HALF + n * 16); }
    }
    __device__ __forceinline__ void operator()(const f32x4 (&acc)[2][2][4][2], const Unit& u, int wr, int wc, int fr, int fq) const {
        const int row0 = u.pm * BM + wr * 64 + fr, col0 = u.pn * BM + wc * 32 + 4 * fq;
#pragma unroll
        for (int ai = 0; ai < 2; ++ai)
#pragma unroll
            for (int m = 0; m < 4; ++m) { const int row = row0 + ai * HALF + m * 16; float* op = out + (size_t)row * DM + col0;
#pragma unroll
                for (int bj = 0; bj < 2; ++bj)
#pragma unroll
                    for (int n = 0; n < 2; ++n) *(f32x4*)(op + bj * HALF + n * 16) = acc[ai][bj][m][n]; }
    }
};

template <class Epi, class Sched>
__device__ __forceinline__ void gemm_phase(LAS unsigned char* lds, const Gemm g, const Sched& S, const Epi& E, const int tid) {
    const int wid = __builtin_amdgcn_readfirstlane(tid >> 6), lane = tid & 63, wr = wid >> 2, wc = wid & 3, fr = lane & 15, fq = lane >> 4;
    const int K = g.K, nt = K / BK;
    unsigned voffA[2], voffB[2];
#pragma unroll
    for (int i = 0; i < 2; ++i) { int R, C; stage_rc(tid * 16 + i * 8192, R, C); const int Rb = Epi::PERM ? ((R & ~31) + perm32(R & 31)) : R;
        voffA[i] = (unsigned)(R * g.lda + C) * 2u; voffB[i] = (unsigned)(Rb * g.ldb + C) * 2u; }
    const size_t kstep = (size_t)(BK * 2);
    const size_t hstepA = (size_t)HALF * g.lda * 2, hstepB = (size_t)HALF * g.ldb * 2;
    const size_t tstepA = 2 * hstepA, tstepB = 2 * hstepB;
    const unsigned ldsw = (unsigned)wid * 1024u;
    const int aoff = lds_byte(wr * 64 + fr, fq * 8), boff = lds_byte(wc * 32 + fr, fq * 8);
#define PG8_SA(b, h) (((b) * 2 + (h)) * HTB)
#define PG8_SB(b, h) ((4 + (b) * 2 + (h)) * HTB)
#define PG8_STAGE(bufoff, gbase, voff) do { _Pragma("unroll") for (int _i = 0; _i < 2; ++_i) \
        __builtin_amdgcn_global_load_lds((const unsigned*)((const char*)(gbase) + (voff)[_i]), (LAS unsigned*)(lds + (bufoff) + ldsw + _i * 8192), 16, 0, 0); } while (0)
#define PG8_LDA(dst, b, h) do { _Pragma("unroll") for (int m = 0; m < 4; ++m) _Pragma("unroll") for (int k = 0; k < 2; ++k) dst[m][k] = *(const LAS bf16x8*)(lds + PG8_SA(b, h) + aoff + m * 2048 + k * 1024); } while (0)
#define PG8_LDB(dst, b, h) do { _Pragma("unroll") for (int n = 0; n < 2; ++n) _Pragma("unroll") for (int k = 0; k < 2; ++k) dst[n][k] = *(const LAS bf16x8*)(lds + PG8_SB(b, h) + boff + n * 2048 + k * 1024); } while (0)
#define PG8_MMA(ai, bj, At, Bt) do { __builtin_amdgcn_s_setprio(1); _Pragma("unroll") for (int m = 0; m < 4; ++m) _Pragma("unroll") for (int n = 0; n < 2; ++n) _Pragma("unroll") for (int k = 0; k < 2; ++k) \
        acc[ai][bj][m][n] = __builtin_amdgcn_mfma_f32_16x16x32_bf16(Bt[n][k], At[m][k], acc[ai][bj][m][n], 0, 0, 0); __builtin_amdgcn_s_setprio(0); } while (0)
#define PG8_WAIT_V(n) asm volatile("s_waitcnt vmcnt(" #n ")" ::: "memory")
#define PG8_WAIT_L(n) asm volatile("s_waitcnt lgkmcnt(" #n ")" ::: "memory")
#define PG8_BAR __builtin_amdgcn_s_barrier()
#define PG8_SCHED __builtin_amdgcn_sched_barrier(0)
    Unit cur, nxt; int ui = 0;
    if (!S.next(0, cur)) return;
    f32x4 acc[2][2][4][2];
    E.init(acc, cur, wr, wc, fr, fq);
    bf16x8 At[4][2], B0[2][2], B1[2][2];
    const char* cA = (const char*)g.A + (size_t)cur.pm * tstepA; const char* cB = (const char*)g.Bt + (size_t)cur.pb * tstepB;
    PG8_STAGE(PG8_SB(0, 0), cB, voffB); PG8_STAGE(PG8_SB(0, 1), cB + hstepB, voffB); PG8_STAGE(PG8_SA(0, 0), cA, voffA); PG8_STAGE(PG8_SA(0, 1), cA + hstepA, voffA);
    if (wr == 1) PG8_BAR;
    PG8_WAIT_V(2); PG8_BAR;
    PG8_STAGE(PG8_SB(1, 0), cB + kstep, voffB); PG8_STAGE(PG8_SA(1, 0), cA + kstep, voffA); PG8_STAGE(PG8_SB(1, 1), cB + hstepB + kstep, voffB);
    PG8_WAIT_V(0); PG8_BAR;
    for (;;) {
        const bool has_next = S.next(ui + 1, nxt);
        const char* nA = has_next ? (const char*)g.A + (size_t)nxt.pm * tstepA : cA; const char* nB = has_next ? (const char*)g.Bt + (size_t)nxt.pb * tstepB : cB;
#pragma unroll 1
        for (int t = 0; t < nt; t += 2) {
            const bool last = (t == nt - 2);
            const char* a1 = cA + (size_t)(t + 1) * kstep;
            const char* a2 = last ? nA : cA + (size_t)(t + 2) * kstep; const char* b2 = last ? nB : cB + (size_t)(t + 2) * kstep;
            const char* a3 = a2 + kstep; const char* b3 = b2 + kstep;
            PG8_LDB(B0, 0, 0); PG8_LDB(B1, 0, 1); PG8_SCHED; PG8_LDA(At, 0, 0); PG8_STAGE(PG8_SA(1, 1), a1 + hstepA, voffA);
            if (t) PG8_WAIT_V(8); PG8_WAIT_L(0); PG8_BAR; PG8_MMA(0, 0, At, B0); PG8_MMA(0, 1, At, B1); PG8_BAR; PG8_SCHED;
            PG8_LDA(At, 0, 1); PG8_STAGE(PG8_SB(0, 0), b2, voffB); PG8_STAGE(PG8_SB(0, 1), b2 + hstepB, voffB); PG8_STAGE(PG8_SA(0, 0), a2, voffA);
            if (t) PG8_WAIT_V(8); PG8_WAIT_L(0); PG8_BAR; PG8_MMA(1, 0, At, B0); PG8_MMA(1, 1, At, B1); PG8_BAR; PG8_SCHED;
            PG8_LDB(B0, 1, 0); PG8_LDB(B1, 1, 1); PG8_SCHED; PG8_LDA(At, 1, 0); PG8_STAGE(PG8_SA(0, 1), a2 + hstepA, voffA);
            PG8_WAIT_V(8); PG8_WAIT_L(0); PG8_BAR; PG8_MMA(0, 0, At, B0); PG8_MMA(0, 1, At, B1); PG8_BAR; PG8_SCHED;
            PG8_LDA(At, 1, 1); PG8_STAGE(PG8_SB(1, 0), b3, voffB); PG8_STAGE(PG8_SB(1, 1), b3 + hstepB, voffB); PG8_STAGE(PG8_SA(1, 0), a3, voffA);
            PG8_WAIT_V(8); PG8_WAIT_L(0); PG8_BAR; PG8_MMA(1, 0, At, B0); PG8_MMA(1, 1, At, B1); PG8_BAR; PG8_SCHED;
        }
        PG8_WAIT_V(0);
        if (wr == 0) PG8_BAR;
        E(acc, cur, wr, wc, fr, fq);
        if (!has_next) break;
        E.init(acc, nxt, wr, wc, fr, fq);
        cur = nxt; cA = nA; cB = nB; ++ui;
        if (wr == 1) PG8_BAR;
    }
    PG8_WAIT_V(0);
    PG8_BAR;
#undef PG8_SA
#undef PG8_SB
#undef PG8_STAGE
#undef PG8_LDA
#undef PG8_LDB
#undef PG8_MMA
#undef PG8_WAIT_V
#undef PG8_WAIT_L
#undef PG8_BAR
#undef PG8_SCHED
}
}

__device__ __forceinline__ int lane_id() { int l; asm volatile("v_mbcnt_lo_u32_b32 %0, -1, 0\n\tv_mbcnt_hi_u32_b32 %0, -1, %0" : "=v"(l)); return l; }
#define RLX_AGENT __ATOMIC_RELAXED, __HIP_MEMORY_SCOPE_AGENT
#define XB_TMO      128
#define XB_XCNT(j)  (256  + 64 * (j))
#define XB_XSUB(j)  (1280 + 64 * (j))
#define XB_XGEN(j)  (2304 + 64 * (j))
#define XB_TOP      3328
#define XB_TOPGEN   3392
#define XCD_BAR_WORDS 3456
#define XB_SPIN_CAP (1u << 22)
__device__ __forceinline__ unsigned xb_ld(unsigned* p)              { return __hip_atomic_load(p, __ATOMIC_RELAXED, __HIP_MEMORY_SCOPE_AGENT); }
__device__ __forceinline__ unsigned xb_add(unsigned* p, unsigned v) { return __hip_atomic_fetch_add(p, v, __ATOMIC_RELAXED, __HIP_MEMORY_SCOPE_AGENT); }
__device__ __forceinline__ unsigned xb_xcc_id() { return (unsigned)__builtin_amdgcn_s_getreg((3 << 11) | 20) & 0xFu; }
#define XB_SPIN(cond, bar) do { unsigned _sp = 0; while (cond) { __builtin_amdgcn_s_sleep(1); \
    if ((++_sp & 255u) == 0u) { if (xb_ld(&(bar)[XB_TMO])) break; if (_sp > XB_SPIN_CAP) { atomicAdd(&(bar)[XB_TMO], 1u); break; } } } } while (0)
struct XcdBarrier { unsigned* bar; unsigned x; volatile LAS unsigned* st; };
__device__ __forceinline__ XcdBarrier xcd_barrier_post(unsigned* bar, volatile LAS unsigned* st, bool leader) {
    XcdBarrier b; b.bar = bar; b.x = xb_xcc_id(); b.st = st;
    if (leader) (void)xb_add(&bar[XB_XCNT(b.x)], 1u);
    return b;
}
__device__ __forceinline__ void xcd_barrier_complete(unsigned* bar, unsigned x, unsigned& nloc, unsigned& nx) {
    const unsigned G = gridDim.x * gridDim.y * gridDim.z;
    unsigned sum, cnt, mine, sp = 0u;
    for (;;) {
        sum = 0u; cnt = 0u; mine = 0u;
#pragma unroll
        for (unsigned j = 0; j < 16; ++j) { const unsigned c = xb_ld(&bar[XB_XCNT(j)]); sum += c; cnt += (c > 0u) ? 1u : 0u; mine = (j == x) ? c : mine; }
        if (sum == G) break;
        __builtin_amdgcn_s_sleep(1);
        if ((++sp & 255u) == 0u) { if (xb_ld(&bar[XB_TMO])) break; if (sp > XB_SPIN_CAP) { atomicAdd(&bar[XB_TMO], 1u); break; } }
    }
    nloc = mine > 0u ? mine : 1u; nx = cnt > 0u ? cnt : 1u;
}
__device__ __forceinline__ void xcd_barrier(const XcdBarrier& b, int wave_s) {
    asm volatile("s_waitcnt vmcnt(0)" ::: "memory");
    __syncthreads();
    if (wave_s == 0 && lane_id() == 0) {
        unsigned* bar = b.bar;
        __builtin_amdgcn_s_waitcnt(0);
        unsigned nloc = b.st[0], nx = b.st[1];
        if (nloc == 0u) { xcd_barrier_complete(bar, b.x, nloc, nx); b.st[0] = nloc; b.st[1] = nx; }
        const unsigned old = xb_add(&bar[XB_XSUB(b.x)], 1u);
        const unsigned gen = old / nloc;
        if (old + 1u == (gen + 1u) * nloc) {
            __builtin_amdgcn_fence(__ATOMIC_RELEASE, "agent");
            asm volatile("s_waitcnt vmcnt(0)" ::: "memory");
            const unsigned og = xb_add(&bar[XB_TOP], 1u);
            const unsigned tg = og / nx;
            if (og + 1u == (tg + 1u) * nx) xb_add(&bar[XB_TOPGEN], 1u);
            else XB_SPIN(xb_ld(&bar[XB_TOPGEN]) == tg, bar);
            __builtin_amdgcn_fence(__ATOMIC_ACQUIRE, "agent");
            xb_add(&bar[XB_XGEN(b.x)], 1u);
            asm volatile("s_waitcnt vmcnt(0)" ::: "memory");
        } else {
            XB_SPIN(xb_ld(&bar[XB_XGEN(b.x)]) == gen, bar);
            __builtin_amdgcn_fence(__ATOMIC_ACQUIRE, "agent");
            asm volatile("s_waitcnt vmcnt(0)" ::: "memory");
        }
    }
    __syncthreads();
}

constexpr int NWAVES = 8;
constexpr int RING_BYTES = 131072;
constexpr int LDSCTL_OFF = RING_BYTES, MISC_OFF = LDSCTL_OFF + 320;
constexpr int LDS_BYTES = 147456;
struct Args { const float* in[31]; float* out; unsigned char* ws; int ph_lo, ph_hi; };
typedef const __attribute__((address_space(4))) Args* KArgs;
__device__ __forceinline__ KArgs opaque(KArgs p) { unsigned long long v = (unsigned long long)p; asm volatile("" : "+s"(v)); return (KArgs)v; }
enum { I_XP = 0, I_XS, I_EVNORM, I_EVWIN, I_S5ARE, I_S5AIM, I_S5LOGDT, I_S5BRE, I_S5BIM, I_S5CRE, I_S5CIM, I_S5D, I_S5GLUW, I_S5GLUB, I_RWMU, I_RWW0, I_RWWUP, I_RWA0, I_RWAUP,
       I_RWKK, I_RWKA, I_RWRK, I_RWLNG, I_RWLNB, I_EVWOUT, I_ODNORM, I_ODWIN, I_ATQN, I_ATKN, I_ATSINK, I_ODWOUT };

__device__ __forceinline__ void transpose_item(const float* W, int K, int N, bf16_t* WT, LAS float* scr, int item, int lane) {
    const int nblk = N / 32, kb = item / nblk, nb = item % nblk, k0 = 64 * kb, n0 = 32 * nb;
#pragma unroll 8
    for (int i = 0; i < 32; ++i) { const int kk = 2 * i + (lane >> 5); scr[kk * 33 + (lane & 31)] = W[(size_t)(k0 + kk) * N + n0 + (lane & 31)]; }
    asm volatile("s_waitcnt lgkmcnt(0)" ::: "memory");
    const int c = lane & 7;
#pragma unroll
    for (int j = 0; j < 4; ++j) { const int n = (lane >> 3) + 8 * j; const LAS float* s = scr + (8 * c) * 33 + n;
        u32x4 o; o.x = pk2(s[0 * 33], s[1 * 33]); o.y = pk2(s[2 * 33], s[3 * 33]); o.z = pk2(s[4 * 33], s[5 * 33]); o.w = pk2(s[6 * 33], s[7 * 33]);
        *(GAS u32x4*)(WT + (size_t)(n0 + n) * K + k0 + 8 * c) = o; }
    asm volatile("s_waitcnt lgkmcnt(0)" ::: "memory");
}

__device__ __forceinline__ void rms_rows2_to_bf16(const float* xrow0, const float* xrow1, const float* gain, bf16_t* orow0, bf16_t* orow1, int lane) {
    const GAS f32x4* xr0 = (const GAS f32x4*)xrow0 + lane; const GAS f32x4* xr1 = (const GAS f32x4*)xrow1 + lane; const GAS f32x4* gr = (const GAS f32x4*)gain + lane;
    f32x4 v0[4], v1[4]; float s0 = 0.f, s1 = 0.f;
#pragma unroll
    for (int j = 0; j < 4; ++j) { v0[j] = xr0[64 * j]; v1[j] = xr1[64 * j]; }
#pragma unroll
    for (int j = 0; j < 4; ++j) { s0 += (v0[j].x * v0[j].x + v0[j].y * v0[j].y) + (v0[j].z * v0[j].z + v0[j].w * v0[j].w); s1 += (v1[j].x * v1[j].x + v1[j].y * v1[j].y) + (v1[j].z * v1[j].z + v1[j].w * v1[j].w); }
    const float r0 = 1.0f / sqrtf(wave_sum_fast(s0) * (1.f / DM) + 1e-6f), r1 = 1.0f / sqrtf(wave_sum_fast(s1) * (1.f / DM) + 1e-6f);
    GAS u32x2* o0 = (GAS u32x2*)orow0 + lane; GAS u32x2* o1 = (GAS u32x2*)orow1 + lane;
#pragma unroll
    for (int j = 0; j < 4; ++j) { const f32x4 gg = gr[64 * j]; u32x2 w;
        w.x = pk2(v0[j].x * r0 * gg.x, v0[j].y * r0 * gg.y); w.y = pk2(v0[j].z * r0 * gg.z, v0[j].w * r0 * gg.w); o0[64 * j] = w;
        w.x = pk2(v1[j].x * r1 * gg.x, v1[j].y * r1 * gg.y); w.y = pk2(v1[j].z * r1 * gg.z, v1[j].w * r1 * gg.w); o1[64 * j] = w; }
}

__device__ __forceinline__ void s5_prep_group(KArgs a, int j, int g, int part, LAS unsigned char* lds, bf16_t* Bmat, bf16_t* W2, const int tid) {
    LAS f32x2* pw = (LAS f32x2*)lds;
    LAS f32x2* bb = pw + 2 * 17 * 64;
    LAS f32x2* cc = bb + 2 * 64 * 16;
    LAS float* Kl = (LAS float*)(cc + 2 * 16 * 64);
    LAS float* Dg = Kl + 2 * 16 * 256;
    const float* a_re = a->in[I_S5ARE]; const float* a_im = a->in[I_S5AIM]; const float* log_dt = a->in[I_S5LOGDT];
    const float* b_re = a->in[I_S5BRE]; const float* b_im = a->in[I_S5BIM]; const float* c_re = a->in[I_S5CRE]; const float* c_im = a->in[I_S5CIM];
    for (int e = tid; e < 2 * 17 * 64; e += 512) { const int d = e / (17 * 64), tau = (e / 64) % 17, n = e & 63; const int gi = ((j * 2 + d) * 32 + g);
        const float dt = __expf(log_dt[gi]), ar = a_re[gi * 64 + n], ai = a_im[gi * 64 + n];
        const float mag = __expf(ar * dt * (float)tau); float sn, cs; __sincosf(ai * dt * (float)tau, &sn, &cs); pw[e] = (f32x2){mag * cs, mag * sn}; }
    for (int e = tid; e < 2 * 64 * 16; e += 512) { const int d = e / 1024, n = (e >> 4) & 63, c = e & 15; const int gi = ((j * 2 + d) * 32 + g);
        const float dt = __expf(log_dt[gi]), ar = a_re[gi * 64 + n], ai = a_im[gi * 64 + n];
        const float mag = __expf(ar * dt); float sn, cs; __sincosf(ai * dt, &sn, &cs); const float lr = mag * cs, li = mag * sn;
        const float den = ar * ar + ai * ai, nr = lr - 1.0f, qr = (nr * ar + li * ai) / den, qi = (li * ar - nr * ai) / den;
        const float br = b_re[((size_t)gi * 64 + n) * 16 + c], bi = b_im[((size_t)gi * 64 + n) * 16 + c];
        bb[e] = (f32x2){qr * br - qi * bi, qr * bi + qi * br}; }
    for (int e = tid; e < 2 * 16 * 64; e += 512) { const int d = e / 1024, c = (e >> 6) & 15, n = e & 63; const int gi = ((j * 2 + d) * 32 + g);
        cc[e] = (f32x2){c_re[((size_t)gi * 16 + c) * 64 + n], c_im[((size_t)gi * 16 + c) * 64 + n]}; }
    if (tid < 16) Dg[tid] = a->in[I_S5D][j * 512 + g * 16 + tid];
    __syncthreads();
    { const int d = tid >> 8, tau = (tid >> 4) & 15, c = tid & 15; float acc[16];
#pragma unroll
        for (int i = 0; i < 16; ++i) acc[i] = 0.f;
        for (int n = 0; n < 64; ++n) { const f32x2 C = cc[(d * 16 + c) * 64 + n], P = pw[(d * 17 + tau) * 64 + n]; const float mr = C.x * P.x - C.y * P.y, mi = C.x * P.y + C.y * P.x;
#pragma unroll
            for (int i = 0; i < 16; ++i) { const f32x2 B = bb[(d * 64 + n) * 16 + i]; acc[i] += mr * B.x - mi * B.y; } }
#pragma unroll
        for (int i = 0; i < 16; ++i) Kl[((d * 16 + tau) * 16 + c) * 16 + i] = acc[i]; }
    __syncthreads();
    bf16_t* W2g = W2 + (size_t)g * 256 * 512; bf16_t* Bg = Bmat + (size_t)g * 256 * 256;
    for (int e = part * 64 * 64 + tid; e < (part + 1) * 64 * 64; e += 512) { const int row = e >> 6, ch = e & 63, t = row >> 4, c = row & 15; float v[8];
        if (ch < 32) { const int s = ch >> 1, c0 = (ch & 1) * 8;
#pragma unroll
            for (int i = 0; i < 8; ++i) { const int cp = c0 + i; float x = 0.f;
                if (s <= t) x += Kl[((0 * 16 + (t - s)) * 16 + c) * 16 + cp];
                if (s >= t) x += Kl[((1 * 16 + (s - t)) * 16 + c) * 16 + cp];
                if (s == t && cp == c) x += Dg[c];
                v[i] = x; }
        } else { const int idx = (ch - 32) * 8, d = idx >> 7, ri = (idx >> 6) & 1, n0 = idx & 63; const int tau = d == 0 ? t + 1 : 16 - t;
#pragma unroll
            for (int i = 0; i < 8; ++i) { const f32x2 C = cc[(d * 16 + c) * 64 + n0 + i], P = pw[(d * 17 + tau) * 64 + n0 + i];
                v[i] = ri == 0 ? (C.x * P.x - C.y * P.y) : -(C.x * P.y + C.y * P.x); }
        }
        *(GAS u32x4*)(W2g + (size_t)row * 512 + ch * 8) = pack8(v); }
    for (int e = part * 64 * 32 + tid; e < (part + 1) * 64 * 32; e += 512) { const int row = e >> 5, ch = e & 31, d = row >> 7, ri = (row >> 6) & 1, n = row & 63, s = ch >> 1, c0 = (ch & 1) * 8; float v[8];
        const f32x2 P = pw[(d * 17 + (d == 0 ? 15 - s : s)) * 64 + n];
#pragma unroll
        for (int i = 0; i < 8; ++i) { const f32x2 B = bb[(d * 64 + n) * 16 + c0 + i]; v[i] = ri == 0 ? (P.x * B.x - P.y * B.y) : (P.x * B.y + P.y * B.x); }
        *(GAS u32x4*)(Bg + (size_t)row * 256 + ch * 8) = pack8(v); }
    __syncthreads();
}

template <bool PASSB>
__device__ __forceinline__ void s5_carry_seg(KArgs a, int j, int unit, const bf16_t* Hend, float* SEGE, bf16_t* UH, int lane) {
    const int segidx = unit >> 6, gd = unit & 63, g = gd >> 1, d = gd & 1;
    const int seq = segidx < 64 ? segidx >> 4 : 4, seg = segidx < 64 ? segidx & 15 : segidx - 64, segbase = segidx - seg;
    const int inst0 = seq < 4 ? seq * 512 : 2048, cnt = seq < 4 ? 512 : 1024;
    const int gi = (j * 2 + d) * 32 + g;
    const float dt = expf(a->in[I_S5LOGDT][gi]), ar = a->in[I_S5ARE][gi * 64 + lane], ai = a->in[I_S5AIM][gi * 64 + lane];
    const float mag = expf(ar * dt * 16.f); float sn, cs; sincosf(ai * dt * 16.f, &sn, &cs); const float lr = mag * cs, li = mag * sn;
    float hr = 0.f, hi = 0.f;
    if (PASSB) { float sr = lr, si = li;
#pragma unroll
        for (int q = 0; q < 5; ++q) { const float nr = sr * sr - si * si, ni = 2.f * sr * si; sr = nr; si = ni; }
        for (int s0 = 0; s0 < seg; s0 += 8) { float er[8], ei[8];
#pragma unroll
            for (int k = 0; k < 8; ++k) { const bool v = s0 + k < seg; const float* p = SEGE + ((size_t)(segbase + (v ? s0 + k : 0)) * 64 + gd) * 128 + lane; er[k] = v ? p[0] : 0.f; ei[k] = v ? p[64] : 0.f; }
#pragma unroll
            for (int k = 0; k < 8; ++k) if (s0 + k < seg) { const float nr = sr * hr - si * hi + er[k], ni = sr * hi + si * hr + ei[k]; hr = nr; hi = ni; } } }
    const GAS bf16_t* hp = (const GAS bf16_t*)Hend + (size_t)g * NINST * 256 + d * 128 + lane;
    GAS bf16_t* up = (GAS bf16_t*)UH + (size_t)g * NINST * 512 + 256 + d * 128 + lane;
    for (int i0 = 0; i0 < 32; i0 += 8) {
        float er[8], ei[8];
#pragma unroll
        for (int k = 0; k < 8; ++k) { const int q = 32 * seg + i0 + k; const int inst = inst0 + (d == 0 ? q : cnt - 1 - q); er[k] = bf2f(hp[(size_t)inst * 256]); ei[k] = bf2f(hp[(size_t)inst * 256 + 64]); }
#pragma unroll
        for (int k = 0; k < 8; ++k) { const int q = 32 * seg + i0 + k; const int inst = inst0 + (d == 0 ? q : cnt - 1 - q);
            if (PASSB) { up[(size_t)inst * 512] = (bf16_t)f2bf(hr); up[(size_t)inst * 512 + 64] = (bf16_t)f2bf(hi); }
            const float nr = lr * hr - li * hi + er[k], ni = lr * hi + li * hr + ei[k]; hr = nr; hi = ni; }
    }
    if (!PASSB) { float* p = SEGE + ((size_t)segidx * 64 + gd) * 128 + lane; p[0] = hr; p[64] = hi; }
}

constexpr int SH_SEG = 128, SH_NSEG = T / SH_SEG;
__device__ __forceinline__ bool seq_first_row(int t) { return t < TP ? (t & 8191) == 0 : t == TP; }
__device__ __forceinline__ bool seq_end_row(int t) { return t < TP ? (t & 8191) == 0 : (t == TP || t == T); }
__device__ __forceinline__ void shift_save_halo(const bf16_t* PRW, bf16_t* HALO, int task, int lane) {
    const int seg = task >> 1, which = task & 1, t0 = seg * SH_SEG;
    const int src = which == 0 ? t0 - 1 : t0 + SH_SEG; const bool valid = which == 0 ? !seq_first_row(t0) : !seq_end_row(t0 + SH_SEG);
    for (int ch = lane; ch < 208; ch += 64) { u32x4 v = {0u, 0u, 0u, 0u}; if (valid) v = *(const GAS u32x4*)(PRW + (size_t)src * PRW_LD + 8 * ch); *(GAS u32x4*)(HALO + ((size_t)task * 1664) + 8 * ch) = v; }
}
__device__ __forceinline__ float tanh_fast_(float x) { return 1.0f - 2.0f * __builtin_amdgcn_rcpf(__expf(2.0f * x) + 1.0f); }
__device__ __forceinline__ void shift_rows(KArgs a, int j, bf16_t* PRW, const bf16_t* HALO, int task, int lane) {
    const int seg = task >> 2, cg = task & 3, ch = cg * 64 + lane, t0 = seg * SH_SEG;
    if (ch >= 208) return;
    const bool is_lw = ch >= 192 && ch < 200;
    float mu[8]; { const f32x4 m0 = *(const GAS f32x4*)(a->in[I_RWMU] + j * 1664 + 8 * ch), m1 = *(const GAS f32x4*)(a->in[I_RWMU] + j * 1664 + 8 * ch + 4);
#pragma unroll
        for (int i = 0; i < 4; ++i) { mu[i] = m0[i]; mu[4 + i] = m1[i]; } }
    GAS bf16_t* base = (GAS bf16_t*)PRW + (size_t)t0 * PRW_LD + 8 * ch;
    float prev[8], cur[8];
    unpack8(*(const GAS u32x4*)(HALO + ((size_t)(2 * seg) * 1664) + 8 * ch), prev); unpack8(*(const GAS u32x4*)base, cur);
    float kkv[8];
#pragma unroll
    for (int i = 0; i < 8; ++i) kkv[i] = 0.f;
    if (cg == 1) { const f32x4 k0 = *(const GAS f32x4*)(a->in[I_RWKK] + j * 512 + 8 * lane), k1 = *(const GAS f32x4*)(a->in[I_RWKK] + j * 512 + 8 * lane + 4);
#pragma unroll
        for (int i = 0; i < 4; ++i) { kkv[i] = k0[i]; kkv[4 + i] = k1[i]; } }
    for (int r0 = 0; r0 < SH_SEG; r0 += 4) { u32x4 nx[4];
#pragma unroll
        for (int u = 0; u < 4; ++u) { const int r = r0 + u + 1; nx[u] = r < SH_SEG ? *(const GAS u32x4*)(base + (size_t)r * PRW_LD) : *(const GAS u32x4*)(HALO + ((size_t)(2 * seg + 1) * 1664) + 8 * ch); }
#pragma unroll
        for (int u = 0; u < 4; ++u) { float nxt[8], o[8]; unpack8(nx[u], nxt); float ss = 0.f;
#pragma unroll
            for (int i = 0; i < 8; ++i) { const float v = cur[i] + mu[i] * (0.5f * (prev[i] + nxt[i]) - cur[i]); o[i] = is_lw ? tanh_fast_(v) : v; prev[i] = cur[i]; cur[i] = nxt[i]; const float t = v * kkv[i]; ss += t * t; }
            *(GAS u32x4*)(base + (size_t)(r0 + u) * PRW_LD) = pack8(o);
            if (cg == 1) { ss = reduce8(ss); if ((lane & 7) == 0) *(GAS float*)((GAS bf16_t*)PRW + (size_t)(t0 + r0 + u) * PRW_LD + 2176 + 2 * (lane >> 3)) = 1.0f / fmaxf(sqrtf(ss), 1e-12f); } } }
}

namespace rw {
constexpr int SC = 512, NSC = T / SC, NUNIT = NSC * 16;
constexpr int WK_BYTES = 65536, IMG_BYTES = 16384;
constexpr int RS = 144;
constexpr int O_W = 0, O_QG = 2304, O_BGT = 4608, O_KGT = 6656, O_VT = 8704, O_AQB = 10752, O_AQK = 11264, O_UT = 11776, O_GC = 15872;
constexpr int TMP_OFF = 32768, TMP_BYTES = 14336;
constexpr int T_LA = 0, T_TW = 2304, T_AG = 4608, T_AGT = 6912, T_BGI = 8960, T_KGI = 11264, T_AAB = 0, T_AAK = 1024, T_TINV = 1536;
#define MFMA16(a, b, c) __builtin_amdgcn_mfma_f32_16x16x32_bf16((a), (b), (c), 0, 0, 0)
__device__ __forceinline__ bf16x8 mk8(u32x2 lo, u32x2 hi) { const u32x4 v = {lo.x, lo.y, hi.x, hi.y}; return __builtin_bit_cast(bf16x8, v); }
__device__ __forceinline__ bf16x8 zero8() { const u32x4 v = {0u, 0u, 0u, 0u}; return __builtin_bit_cast(bf16x8, v); }
__device__ __forceinline__ void wave_lds_fence() { asm volatile("s_waitcnt lgkmcnt(0)" ::: "memory"); __builtin_amdgcn_wave_barrier(); asm volatile("" ::: "memory"); }

template <bool P3>
__device__ __forceinline__ void s1_issue(const bf16_t* PRW, int h, int d, int e, long sc_row0, int p0, int lane, u32x4 (&rl)[2][2], u32x2 (&rk4)[4], u32x2 (&rr)[2], u32x2 (&rv)[2]) {
    const int lr = lane & 15, kq = lane >> 4;
    const int tsc = d ? (SC - 1) - (p0 + lr) : (p0 + lr); const GAS bf16_t* rp = (const GAS bf16_t*)PRW + (sc_row0 + tsc) * PRW_LD;
#pragma unroll
    for (int ks = 0; ks < 2; ++ks) { rl[0][ks] = *(const GAS u32x4*)(rp + 1536 + 32 * ks + 8 * kq); rl[1][ks] = *(const GAS u32x4*)(rp + 1600 + 32 * ks + 8 * kq); }
#pragma unroll
    for (int cl = 0; cl < 2; ++cl) rk4[cl] = *(const GAS u32x2*)(rp + 512 + 64 * h + 16 * (2 * e + cl) + 4 * kq);
    rk4[2].x = *(const GAS unsigned*)(rp + 2176 + 2 * h); rk4[2].y = 0u; rk4[3] = (u32x2){0u, 0u};
#pragma unroll
    for (int cl = 0; cl < 2; ++cl) { rr[cl] = (u32x2){0u, 0u}; rv[cl] = *(const GAS u32x2*)(rp + 1024 + 64 * h + 16 * (2 * e + cl) + 4 * kq); }
}
constexpr int CST_OFF = 61440;
constexpr int BSP_OFF = 64256;

template <bool P3, int VAR = 0>
__device__ __forceinline__ void stage1(int h, int d, int s, int e, long sc_row0, int p0, bool nxt, LAS unsigned char* wl, const bf16_t* PRW, const bf16_t* aupT, const bf16x8 (&lwAp)[2][2], const bf16x8 (&lwW)[2][2], bf16_t* BON,
                                       int lane, u32x4 (&rl)[2][2], u32x2 (&rk4)[4], u32x2 (&rr)[2], u32x2 (&rv)[2]) {
    LAS unsigned char* img = wl + s * IMG_BYTES; LAS unsigned char* tmp = wl + TMP_OFF + s * TMP_BYTES; const LAS float* cst = (const LAS float*)(wl + CST_OFF);
    LAS float* bsp = (LAS float*)(wl + BSP_OFF) + s * 32;
    const int lr = lane & 15, kq = lane >> 4;
    const int tsc = d ? (SC - 1) - (p0 + lr) : (p0 + lr); const long row = sc_row0 + tsc;
    float kx[8], rx[8], vx[8]; float inv;
    bf16x8 lwA[2][2];
#pragma unroll
    for (int cl = 0; cl < 2; ++cl)
#pragma unroll
        for (int ks = 0; ks < 2; ++ks) lwA[cl][ks] = lwAp[cl][ks];
    if (P3) {
#pragma unroll
        for (int cl = 0; cl < 2; ++cl) rr[cl] = *(const GAS u32x2*)((const GAS bf16_t*)PRW + row * PRW_LD + 64 * h + 16 * (2 * e + cl) + 4 * kq); }
    { inv = __builtin_bit_cast(float, rk4[2].x);
#pragma unroll
        for (int cl = 0; cl < 2; ++cl) { const int c0 = 16 * (2 * e + cl) + 4 * kq; const u32x2 wk = rk4[cl], wr = rr[cl], wv = rv[cl];
            kx[4 * cl] = bflo(wk.x); kx[4 * cl + 1] = bfhi(wk.x); kx[4 * cl + 2] = bflo(wk.y); kx[4 * cl + 3] = bfhi(wk.y);
            rx[4 * cl] = bflo(wr.x); rx[4 * cl + 1] = bfhi(wr.x); rx[4 * cl + 2] = bflo(wr.y); rx[4 * cl + 3] = bfhi(wr.y);
            vx[4 * cl] = bflo(wv.x); vx[4 * cl + 1] = bfhi(wv.x); vx[4 * cl + 2] = bflo(wv.y); vx[4 * cl + 3] = bfhi(wv.y);
            *(LAS bf16_t*)(img + O_VT + ((c0 + 0) * 16 + lr) * 2) = (bf16_t)(wv.x & 0xffffu); *(LAS bf16_t*)(img + O_VT + ((c0 + 1) * 16 + lr) * 2) = (bf16_t)(wv.x >> 16);
            *(LAS bf16_t*)(img + O_VT + ((c0 + 2) * 16 + lr) * 2) = (bf16_t)(wv.y & 0xffffu); *(LAS bf16_t*)(img + O_VT + ((c0 + 3) * 16 + lr) * 2) = (bf16_t)(wv.y >> 16); } }
    f32x4 accA[2], accW[2];
#pragma unroll
    for (int cl = 0; cl < 2; ++cl) { accA[cl] = (f32x4){0.f, 0.f, 0.f, 0.f}; accW[cl] = (f32x4){0.f, 0.f, 0.f, 0.f}; }
    if (!(VAR & 8))
#pragma unroll
    for (int ks = 0; ks < 2; ++ks) { const bf16x8 btw = __builtin_bit_cast(bf16x8, rl[0][ks]), bla = __builtin_bit_cast(bf16x8, rl[1][ks]);
#pragma unroll
        for (int cl = 0; cl < 2; ++cl) { accA[cl] = MFMA16(lwA[cl][ks], bla, accA[cl]); accW[cl] = MFMA16(lwW[cl][ks], btw, accW[cl]); } }
    float av[8], G[8];
#pragma unroll
    for (int cl = 0; cl < 2; ++cl) { const int c0 = 16 * (2 * e + cl) + 4 * kq;
        const f32x4 a0 = *(const LAS f32x4*)(cst + 5 * 64 + c0), w0 = *(const LAS f32x4*)(cst + 6 * 64 + c0);
#pragma unroll
        for (int r = 0; r < 4; ++r) { const int ix = 4 * cl + r; av[ix] = sigmoidf_(a0[r] + accA[cl][r]);
            const float lw = -0.6065306597126334f * sigmoidf_(w0[r] + accW[cl][r]);
            float x = lw; x += dpp_f<0x111>(x); x += dpp_f<0x112>(x); x += dpp_f<0x114>(x); x += dpp_f<0x118>(x); G[ix] = x; } }
    if (lr == 15) {
#pragma unroll
        for (int cl = 0; cl < 2; ++cl) *(LAS f32x4*)(img + O_GC + (16 * (2 * e + cl) + 4 * kq) * 4) = (f32x4){__expf(G[4 * cl]), __expf(G[4 * cl + 1]), __expf(G[4 * cl + 2]), __expf(G[4 * cl + 3])}; }
    float bs = 0.f;
#pragma unroll
    for (int cl = 0; cl < 2; ++cl) { float ag[4], bgi[4], kgi[4], qg[4]; const int c0 = 16 * (2 * e + cl) + 4 * kq;
        const f32x4 kk = *(const LAS f32x4*)(cst + 7 * 64 + c0), ka = *(const LAS f32x4*)(cst + 8 * 64 + c0), rk = *(const LAS f32x4*)(cst + 9 * 64 + c0);
#pragma unroll
        for (int r = 0; r < 4; ++r) { const int ix = 4 * cl + r; const float kap = kx[ix] * kk[r] * inv, b = kap * av[ix], k2 = kx[ix] * (1.0f + (av[ix] - 1.0f) * ka[r]);
            const float eg = __expf(G[ix]); const float egx = __builtin_bit_cast(float, __builtin_amdgcn_update_dpp(0x3f800000, __builtin_bit_cast(int, eg), 0x111, 0xf, 0xf, false));
            const float einv = __builtin_amdgcn_rcpf(eg);
            ag[r] = -kap * egx; bgi[r] = b * einv; kgi[r] = k2 * einv; qg[r] = rx[ix] * eg;
            if (P3) bs += rx[ix] * k2 * rk[r]; }
        u32x2 w;
        w.x = pk2(ag[0], ag[1]); w.y = pk2(ag[2], ag[3]); *(LAS u32x2*)(tmp + T_AG + lr * RS + c0 * 2) = w;
        w.x = pk2(bgi[0], bgi[1]); w.y = pk2(bgi[2], bgi[3]); *(LAS u32x2*)(tmp + T_BGI + lr * RS + c0 * 2) = w;
        w.x = pk2(kgi[0], kgi[1]); w.y = pk2(kgi[2], kgi[3]); *(LAS u32x2*)(tmp + T_KGI + lr * RS + c0 * 2) = w;
        if (P3) { w.x = pk2(qg[0], qg[1]); w.y = pk2(qg[2], qg[3]); *(LAS u32x2*)(img + O_QG + lr * RS + c0 * 2) = w; }
#pragma unroll
        for (int r = 0; r < 4; ++r) { *(LAS bf16_t*)(tmp + T_AGT + ((c0 + r) * 16 + lr) * 2) = (bf16_t)f2bf(ag[r]);
            *(LAS bf16_t*)(img + O_BGT + ((c0 + r) * 16 + lr) * 2) = (bf16_t)f2bf(bgi[r]); *(LAS bf16_t*)(img + O_KGT + ((c0 + r) * 16 + lr) * 2) = (bf16_t)f2bf(kgi[r]); }
        asm volatile("" ::: "memory"); }
    if (P3) { bs += __shfl_xor(bs, 16); bs += __shfl_xor(bs, 32); if (kq == 0) bsp[e * 16 + lr] = bs; }
    __syncthreads();
    if (P3 && d == 0) { const float bt = bsp[lr] + bsp[16 + lr];
#pragma unroll
        for (int cl = 0; cl < 2; ++cl) { const int c0 = 16 * (2 * e + cl) + 4 * kq; u32x2 w; w.x = pk2(bt * vx[4 * cl], bt * vx[4 * cl + 1]); w.y = pk2(bt * vx[4 * cl + 2], bt * vx[4 * cl + 3]); *(GAS u32x2*)(BON + row * 512 + 64 * h + c0) = w; } }
    if (e == 0) {
        f32x4 dab = {0.f, 0.f, 0.f, 0.f}, dak = dab;
#pragma unroll
        for (int ks = 0; ks < 2; ++ks) { const int o = lr * RS + (32 * ks + 8 * kq) * 2;
            const bf16x8 fa = *(const LAS bf16x8*)(tmp + T_AG + o), fb = *(const LAS bf16x8*)(tmp + T_BGI + o), fk = *(const LAS bf16x8*)(tmp + T_KGI + o);
            dab = MFMA16(fa, fb, dab);
            dak = MFMA16(fk, fa, dak); }
        f32x4 lt; u32x2 w; float m[4];
#pragma unroll
        for (int r = 0; r < 4; ++r) lt[r] = (lr < 4 * kq + r) ? dab[r] : 0.f;
        *(LAS f32x4*)(tmp + T_AAB + (lr * 16 + 4 * kq) * 4) = lt;
#pragma unroll
        for (int r = 0; r < 4; ++r) m[r] = (4 * kq + r < lr) ? dak[r] : 0.f;
        w.x = pk2(m[0], m[1]); w.y = pk2(m[2], m[3]); *(LAS u32x2*)(tmp + T_AAK + (lr * 16 + 4 * kq) * 2) = w;
        wave_lds_fence();
        float x[16];
#pragma unroll
        for (int c2 = 7; c2 >= 0; --c2) { f32x4 l4[2][4];
#pragma unroll
            for (int cc = 0; cc < 2; ++cc)
#pragma unroll
                for (int q4 = 0; q4 < 4; ++q4) l4[cc][q4] = *(const LAS f32x4*)(tmp + T_AAB + ((2 * c2 + cc) * 16 + 4 * q4) * 4);
#pragma unroll
            for (int cc = 1; cc >= 0; --cc) { const int cidx = 2 * c2 + cc; float sacc = (lr == cidx) ? 1.f : 0.f;
#pragma unroll
                for (int i = 1; i < 16; ++i) if (i > cidx) sacc += x[i] * l4[cc][i >> 2][i & 3];
                x[cidx] = sacc; }
            asm volatile("" ::: "memory"); }
        if (kq == 0) { float lo8[8], hi8[8];
#pragma unroll
            for (int i = 0; i < 8; ++i) { lo8[i] = x[i]; hi8[i] = x[8 + i]; }
            *(LAS u32x4*)(tmp + T_TINV + lr * 32) = pack8(lo8); *(LAS u32x4*)(tmp + T_TINV + lr * 32 + 16) = pack8(hi8); }
    } else if (P3) {
        f32x4 dqb = {0.f, 0.f, 0.f, 0.f}, dqk = dqb;
#pragma unroll
        for (int ks = 0; ks < 2; ++ks) { const int o = lr * RS + (32 * ks + 8 * kq) * 2;
            const bf16x8 fb = *(const LAS bf16x8*)(tmp + T_BGI + o), fk = *(const LAS bf16x8*)(tmp + T_KGI + o), fq = *(const LAS bf16x8*)(img + O_QG + o);
            dqb = MFMA16(fb, fq, dqb);
            dqk = MFMA16(fk, fq, dqk); }
        u32x2 w; float m[4];
#pragma unroll
        for (int r = 0; r < 4; ++r) m[r] = (4 * kq + r <= lr) ? dqb[r] : 0.f;
        w.x = pk2(m[0], m[1]); w.y = pk2(m[2], m[3]); *(LAS u32x2*)(img + O_AQB + (lr * 16 + 4 * kq) * 2) = w;
#pragma unroll
        for (int r = 0; r < 4; ++r) m[r] = (4 * kq + r <= lr) ? dqk[r] : 0.f;
        w.x = pk2(m[0], m[1]); w.y = pk2(m[2], m[3]); *(LAS u32x2*)(img + O_AQK + (lr * 16 + 4 * kq) * 2) = w;
    }
    asm volatile("" ::: "memory");
    if (nxt && !(VAR & 4)) s1_issue<P3>(PRW, h, d, e, sc_row0, p0 + 32, lane, rl, rk4, rr, rv);
    __syncthreads();
    { const bf16x8 tB = kq < 2 ? *(const LAS bf16x8*)(tmp + T_TINV + (lr * 16 + 8 * kq) * 2) : zero8();
        const bf16x8 tA = mk8(*(const LAS u32x2*)(tmp + T_TINV + (lr * 16 + 4 * kq) * 2), (u32x2){0u, 0u});
        const bf16x8 akA = kq < 2 ? *(const LAS bf16x8*)(tmp + T_AAK + (lr * 16 + 8 * kq) * 2) : zero8();
#pragma unroll
        for (int cl = 0; cl < 2; ++cl) { const int ct = 2 * e + cl; const bf16x8 gA = kq < 2 ? *(const LAS bf16x8*)(tmp + T_AGT + ((16 * ct + lr) * 16 + 8 * kq) * 2) : zero8();
            const f32x4 wv = MFMA16(gA, tB, ((f32x4){0.f, 0.f, 0.f, 0.f}));
            u32x2 w; w.x = pk2(wv[0], wv[1]); w.y = pk2(wv[2], wv[3]); *(LAS u32x2*)(img + O_W + lr * RS + (16 * ct + 4 * kq) * 2) = w;
            const bf16x8 vB = kq < 2 ? *(const LAS bf16x8*)(img + O_VT + ((16 * ct + lr) * 16 + 8 * kq) * 2) : zero8();
            const f32x4 avd = MFMA16(akA, vB, ((f32x4){0.f, 0.f, 0.f, 0.f}));
            const bf16x8 avB = mk8((u32x2){pk2(avd[0], avd[1]), pk2(avd[2], avd[3])}, (u32x2){0u, 0u});
            const f32x4 ut = MFMA16(tA, avB, ((f32x4){0.f, 0.f, 0.f, 0.f}));
#pragma unroll
            for (int r = 0; r < 4; ++r) *(LAS float*)(img + O_UT + ((4 * kq + r) * 64 + 16 * ct + lr) * 4) = ut[r]; } }
}

template <bool P3>
__device__ __forceinline__ void stage2(LAS unsigned char* img, f32x4 (&hk)[4], f32x4 (&pk)[4], int wv, int lane, bf16_t* Yrow0, int d, int p0) {
    const int lr = lane & 15, kq = lane >> 4;
    const bf16x8 hB0 = mk8((u32x2){pk2(hk[0][0], hk[0][1]), pk2(hk[0][2], hk[0][3])}, (u32x2){pk2(hk[1][0], hk[1][1]), pk2(hk[1][2], hk[1][3])});
    const bf16x8 hB1 = mk8((u32x2){pk2(hk[2][0], hk[2][1]), pk2(hk[2][2], hk[2][3])}, (u32x2){pk2(hk[3][0], hk[3][1]), pk2(hk[3][2], hk[3][3])});
    const bf16x8 wA0 = mk8(*(const LAS u32x2*)(img + O_W + lr * RS + (4 * kq) * 2), *(const LAS u32x2*)(img + O_W + lr * RS + (16 + 4 * kq) * 2));
    const bf16x8 wA1 = mk8(*(const LAS u32x2*)(img + O_W + lr * RS + (32 + 4 * kq) * 2), *(const LAS u32x2*)(img + O_W + lr * RS + (48 + 4 * kq) * 2));
    f32x4 u;
#pragma unroll
    for (int r = 0; r < 4; ++r) u[r] = *(const LAS float*)(img + O_UT + ((4 * kq + r) * 64 + 16 * wv + lr) * 4);
    u = MFMA16(wA0, hB0, u); u = MFMA16(wA1, hB1, u);
    const bf16x8 uB = mk8((u32x2){pk2(u[0], u[1]), pk2(u[2], u[3])}, (u32x2){0u, 0u});
    const bf16x8 vB = kq < 2 ? *(const LAS bf16x8*)(img + O_VT + ((16 * wv + lr) * 16 + 8 * kq) * 2) : zero8();
    if (P3) {
        const bf16x8 qA0 = mk8(*(const LAS u32x2*)(img + O_QG + lr * RS + (4 * kq) * 2), *(const LAS u32x2*)(img + O_QG + lr * RS + (16 + 4 * kq) * 2));
        const bf16x8 qA1 = mk8(*(const LAS u32x2*)(img + O_QG + lr * RS + (32 + 4 * kq) * 2), *(const LAS u32x2*)(img + O_QG + lr * RS + (48 + 4 * kq) * 2));
        const bf16x8 bA = mk8(*(const LAS u32x2*)(img + O_AQB + (lr * 16 + 4 * kq) * 2), (u32x2){0u, 0u});
        const bf16x8 kA = kq < 2 ? *(const LAS bf16x8*)(img + O_AQK + (lr * 16 + 8 * kq) * 2) : zero8();
        f32x4 o = {0.f, 0.f, 0.f, 0.f};
        o = MFMA16(qA0, hB0, o); o = MFMA16(qA1, hB1, o); o = MFMA16(bA, uB, o); o = MFMA16(kA, vB, o);
#pragma unroll
        for (int r = 0; r < 4; ++r) { const int p = p0 + 4 * kq + r; const int tsc = d ? (SC - 1) - p : p; Yrow0[(size_t)tsc * 512 + 16 * wv + lr] = (bf16_t)f2bf(o[r]); }
    } else {
        const bf16x8 pB0 = mk8((u32x2){pk2(pk[0][0], pk[0][1]), pk2(pk[0][2], pk[0][3])}, (u32x2){pk2(pk[1][0], pk[1][1]), pk2(pk[1][2], pk[1][3])});
        const bf16x8 pB1 = mk8((u32x2){pk2(pk[2][0], pk[2][1]), pk2(pk[2][2], pk[2][3])}, (u32x2){pk2(pk[3][0], pk[3][1]), pk2(pk[3][2], pk[3][3])});
        f32x4 up = {0.f, 0.f, 0.f, 0.f}; up = MFMA16(wA0, pB0, up); up = MFMA16(wA1, pB1, up);
        const bf16x8 upB = mk8((u32x2){pk2(up[0], up[1]), pk2(up[2], up[3])}, (u32x2){0u, 0u});
#pragma unroll
        for (int kt = 0; kt < 4; ++kt) { const f32x4 gc = *(const LAS f32x4*)(img + O_GC + (16 * kt + 4 * kq) * 4);
            const bf16x8 bgA = mk8(*(const LAS u32x2*)(img + O_BGT + ((16 * kt + lr) * 16 + 4 * kq) * 2), (u32x2){0u, 0u});
            pk[kt] = MFMA16(bgA, upB, pk[kt]) * gc; }
    }
    asm volatile("" ::: "memory");
#pragma unroll
    for (int kt = 0; kt < 4; ++kt) { const f32x4 gc = *(const LAS f32x4*)(img + O_GC + (16 * kt + 4 * kq) * 4);
        const bf16x8 bgA = mk8(*(const LAS u32x2*)(img + O_BGT + ((16 * kt + lr) * 16 + 4 * kq) * 2), (u32x2){0u, 0u});
        const bf16x8 kgA = kq < 2 ? *(const LAS bf16x8*)(img + O_KGT + ((16 * kt + lr) * 16 + 8 * kq) * 2) : zero8();
        f32x4 hn = hk[kt]; hn = MFMA16(bgA, uB, hn); hn = MFMA16(kgA, vB, hn); hk[kt] = hn * gc; }
}

template <bool P3, int VAR = 0>
__device__ __forceinline__ void unit_pair(KArgs a, int j, int item, LAS unsigned char* lds, const bf16_t* PRW, const bf16_t* lora, float* PS, float* HS, bf16_t* Y0, bf16_t* Y1, bf16_t* BON, bf16_t* MIX, int tid) {
    const int lane = tid & 63, wid = __builtin_amdgcn_readfirstlane(tid >> 6), wk = wid >> 2, wv = wid & 3, lr = lane & 15, kq = lane >> 4;
    const int sc = item >> 3, h = item & 7, d = wk;
    const long sc_row0 = (long)sc * SC;
    const int unit = (sc * 8 + h) * 2 + d;
    LAS unsigned char* wl = lds + wk * WK_BYTES;
    LAS float* cst = (LAS float*)(wl + CST_OFF);
    const bf16_t* aupT = lora; const bf16_t* wupT = lora + (size_t)(1 + d) * 512 * 64;
    { const int t = tid & 255;
        for (int e = t; e < 640; e += 256) { const int which = e >> 6, cc = e & 63; float v;
            if (which < 5) v = 0.f;
            else if (which == 5) v = a->in[I_RWA0][j * 512 + 64 * h + cc];
            else if (which == 6) v = a->in[I_RWW0][(j * 2 + d) * 512 + 64 * h + cc];
            else if (which == 7) v = a->in[I_RWKK][j * 512 + 64 * h + cc];
            else if (which == 8) v = a->in[I_RWKA][j * 512 + 64 * h + cc];
            else v = a->in[I_RWRK][j * 512 + 64 * h + cc];
            cst[e] = v; } }
    f32x4 hk[4], pk[4];
#pragma unroll
    for (int kt = 0; kt < 4; ++kt) {
#pragma unroll
        for (int r = 0; r < 4; ++r) { const int k = 16 * kt + 4 * kq + r;
            hk[kt][r] = P3 ? HS[(size_t)unit * 4096 + k * 64 + 16 * wv + lr] : 0.f; pk[kt][r] = (k == 16 * wv + lr) ? 1.f : 0.f; } }
    const int s1 = wv & 1, e1 = wv >> 1;
    bf16_t* Yrow0 = (d == 0 ? Y0 : Y1) + sc_row0 * 512 + 64 * h;
    u32x4 rl[2][2]; u32x2 rk4[4], rr[2], rv[2];
    bf16x8 lwW[2][2], lwAp[2][2];
#pragma unroll
    for (int cl = 0; cl < 2; ++cl)
#pragma unroll
        for (int ks = 0; ks < 2; ++ks) { const size_t wo = (size_t)(64 * h + 16 * (2 * e1 + cl) + lr) * 64 + 32 * ks + 8 * kq; lwW[cl][ks] = *(const GAS bf16x8*)(wupT + wo); lwAp[cl][ks] = *(const GAS bf16x8*)(aupT + wo); }
    s1_issue<P3>(PRW, h, d, e1, sc_row0, 16 * s1, lane, rl, rk4, rr, rv);
    __syncthreads();
#pragma unroll 1
    for (int m = 0; m < SC / 32; ++m) {
        int ln = lane; asm volatile("" : "+v"(ln));
        if (!(VAR & 1)) stage1<P3, VAR>(h, d, s1, e1, sc_row0, 32 * m + 16 * s1, m + 1 < SC / 32, wl, PRW, aupT, lwAp, lwW, BON, ln, rl, rk4, rr, rv);
        __syncthreads();
        if (!(VAR & 2)) { asm volatile("" : "+v"(ln) :: "memory"); stage2<P3>(wl, hk, pk, wv, ln, Yrow0, d, 32 * m);
        stage2<P3>(wl + IMG_BYTES, hk, pk, wv, ln, Yrow0, d, 32 * m + 16); }
        asm volatile("" ::: "memory"); __syncthreads();
    }
    if (P3) {
        asm volatile("s_waitcnt vmcnt(0)" ::: "memory"); __syncthreads();
        const int ch = 64 * h + 8 * (tid & 7); float g[8], b[8];
        { const f32x4 g0 = *(const GAS f32x4*)(a->in[I_RWLNG] + j * 512 + ch), g1 = *(const GAS f32x4*)(a->in[I_RWLNG] + j * 512 + ch + 4), b0 = *(const GAS f32x4*)(a->in[I_RWLNB] + j * 512 + ch), b1 = *(const GAS f32x4*)(a->in[I_RWLNB] + j * 512 + ch + 4);
#pragma unroll
          for (int i = 0; i < 4; ++i) { g[i] = g0[i]; g[4 + i] = g1[i]; b[i] = b0[i]; b[4 + i] = b1[i]; } }
        for (int pass0 = 0; pass0 < SC / 64; pass0 += 4) {
            u32x4 ya[4], yb[4], bo[4], zz[4];
#pragma unroll
            for (int u = 0; u < 4; ++u) { const size_t row = (size_t)sc_row0 + (pass0 + u) * 64 + (tid >> 3); const size_t o = row * 512 + ch;
                ya[u] = *(const GAS u32x4*)(Y0 + o); yb[u] = *(const GAS u32x4*)(Y1 + o); bo[u] = *(const GAS u32x4*)(BON + o); zz[u] = *(const GAS u32x4*)(PRW + row * PRW_LD + 1664 + ch); }
#pragma unroll
            for (int u = 0; u < 4; ++u) { const size_t row = (size_t)sc_row0 + (pass0 + u) * 64 + (tid >> 3);
                float y0[8], y1[8], bn[8], z[8], ov[8];
                unpack8(ya[u], y0); unpack8(yb[u], y1); unpack8(bo[u], bn); unpack8(zz[u], z);
                float sm = 0.f;
#pragma unroll
                for (int i = 0; i < 8; ++i) { y0[i] += y1[i]; sm += y0[i]; }
                const float mean = reduce8(sm) * (1.f / 64.f); float sv = 0.f;
#pragma unroll
                for (int i = 0; i < 8; ++i) { y0[i] -= mean; sv += y0[i] * y0[i]; }
                const float rstd = 1.0f / sqrtf(reduce8(sv) * (1.f / 64.f) + 64e-5f);
#pragma unroll
                for (int i = 0; i < 8; ++i) ov[i] = (y0[i] * rstd * g[i] + b[i] + bn[i]) * siluf_(z[i]);
                *(GAS u32x4*)(MIX + row * 1024 + 512 + ch) = pack8(ov); } }
    }
    if (!P3) {
#pragma unroll
        for (int kt = 0; kt < 4; ++kt)
#pragma unroll
            for (int r = 0; r < 4; ++r) { const int k = 16 * kt + 4 * kq + r; HS[(size_t)unit * 4096 + k * 64 + 16 * wv + lr] = hk[kt][r]; PS[(size_t)unit * 4096 + k * 64 + 16 * wv + lr] = pk[kt][r]; } }
}

__device__ __forceinline__ void chain_states(int chain, LAS unsigned char* lds, const float* PS, float* HS, int tid) {
    int seq, h, d;
    if (chain < 16) { seq = 4; h = chain >> 1; d = chain & 1; } else { const int c = chain - 16; seq = c >> 4; h = (c >> 1) & 7; d = c & 1; }
    const int sc0 = seq < 4 ? seq * 16 : 64, n = seq < 4 ? 16 : 32;
    LAS float* cur = (LAS float*)lds;
    const int k = tid >> 3, vg = (tid & 7) * 8;
    { float z = 0.f; asm volatile("" : "+v"(z));
#pragma unroll
      for (int i = 0; i < 8; ++i) cur[k * 64 + vg + i] = z; }
    f32x4 pr[16], hs0, hs1;
    { const int sc = d ? sc0 + n - 1 : sc0; const size_t uo = (size_t)((sc * 8 + h) * 2 + d) * 4096;
      hs0 = *(const GAS f32x4*)(HS + uo + k * 64 + vg); hs1 = *(const GAS f32x4*)(HS + uo + k * 64 + vg + 4);
#pragma unroll
      for (int q = 0; q < 16; ++q) pr[q] = *(const GAS f32x4*)(PS + uo + k * 64 + 4 * q); }
    __syncthreads();
    for (int i = 0; i < n; ++i) { const int sc = d ? sc0 + n - 1 - i : sc0 + i; const size_t uo = (size_t)((sc * 8 + h) * 2 + d) * 4096;
        float acc[8] = {hs0[0], hs0[1], hs0[2], hs0[3], hs1[0], hs1[1], hs1[2], hs1[3]};
        f32x4 pc[16];
#pragma unroll
        for (int q = 0; q < 16; ++q) pc[q] = pr[q];
        if (i + 1 < n) { const int sn = d ? sc0 + n - 2 - i : sc0 + i + 1; const size_t un = (size_t)((sn * 8 + h) * 2 + d) * 4096;
            hs0 = *(const GAS f32x4*)(HS + un + k * 64 + vg); hs1 = *(const GAS f32x4*)(HS + un + k * 64 + vg + 4);
#pragma unroll
            for (int q = 0; q < 16; ++q) pr[q] = *(const GAS f32x4*)(PS + un + k * 64 + 4 * q); }
#pragma unroll
        for (int q = 0; q < 16; ++q) {
#pragma unroll
            for (int e = 0; e < 4; ++e) { const f32x4 c0 = *(const LAS f32x4*)(cur + (4 * q + e) * 64 + vg), c1 = *(const LAS f32x4*)(cur + (4 * q + e) * 64 + vg + 4); const float p = pc[q][e];
                acc[0] += p * c0[0]; acc[1] += p * c0[1]; acc[2] += p * c0[2]; acc[3] += p * c0[3]; acc[4] += p * c1[0]; acc[5] += p * c1[1]; acc[6] += p * c1[2]; acc[7] += p * c1[3]; } }
        const f32x4 o0 = *(const LAS f32x4*)(cur + k * 64 + vg), o1 = *(const LAS f32x4*)(cur + k * 64 + vg + 4);
        *(GAS f32x4*)(HS + uo + k * 64 + vg) = o0; *(GAS f32x4*)(HS + uo + k * 64 + vg + 4) = o1;
        __syncthreads();
        *(LAS f32x4*)(cur + k * 64 + vg) = (f32x4){acc[0], acc[1], acc[2], acc[3]}; *(LAS f32x4*)(cur + k * 64 + vg + 4) = (f32x4){acc[4], acc[5], acc[6], acc[7]};
        __syncthreads(); }
}
}

__device__ __forceinline__ int crow(int r, int hi) { return (r & 3) + 8 * (r >> 2) + 4 * hi; }
constexpr int AT_KSTR = 144;
constexpr int AT_VSTR = 128;
constexpr int AT_VOFF = 384 * AT_KSTR;
__device__ __forceinline__ float attn_mref2(KArgs a, int j) {
    int ln = lane_id(); float gqm = fabsf(a->in[I_ATQN][j * 64 + ln]), gkm = fabsf(a->in[I_ATKN][j * 64 + ln]);
#pragma unroll
    for (int o = 1; o < 64; o <<= 1) { gqm = fmaxf(gqm, __shfl_xor(gqm, o)); gkm = fmaxf(gkm, __shfl_xor(gkm, o)); }
    return __builtin_bit_cast(float, __builtin_amdgcn_readfirstlane(__builtin_bit_cast(int, 8.2f * gqm * gkm * 1.4426950408889634f))); }
__device__ __forceinline__ void lds_barrier() { asm volatile("s_waitcnt lgkmcnt(0)" ::: "memory"); __builtin_amdgcn_s_barrier(); asm volatile("" ::: "memory"); }
template <int AVAR = 0>
__device__ __forceinline__ void attn_unit(KArgs a, int j, int unit, LAS unsigned char* lds, const bf16_t* PO, bf16_t* MIX, const int tid, const float mref2) {
    const int qbg = unit >> 2, kvh = unit & 3;
    const int t0 = qbg * 128; const int row0 = t0 < TP ? (t0 & ~8191) : TP, Ls = t0 < TP ? 8192 : 16384;
    const int qb = (t0 - row0) >> 7, nb = Ls >> 7;
    const int lane = tid & 63, wid = __builtin_amdgcn_readfirstlane(tid >> 6), q = lane & 31, hi = lane >> 5;
    const float LOG2E = 1.4426950408889634f;
    u32x4 qraw[4];
    { const int item = wid, g = item >> 2, qi = item & 3, hh = 4 * kvh + g; const size_t qrow = (size_t)(t0 + 32 * qi + q);
#pragma unroll
        for (int ks = 0; ks < 4; ++ks) qraw[ks] = *(const GAS u32x4*)(PO + qrow * OD_N + 64 * hh + 16 * ks + 8 * hi); }
    if (!(AVAR & 1)) { const float* gk = a->in[I_ATKN] + j * 64; const float* gqs = a->in[I_ATQN] + j * 64; int tid_s = tid; asm volatile("" : "+v"(tid_s));
#pragma unroll
        for (int i = 0; i < 6; ++i) { const int id = i * 512 + tid_s, srel = id >> 3, ch = id & 7; const int kb = i >> 1; const int blk = qb - 1 + kb;
            if (blk >= 0 && blk < nb) { const bf16_t* ub = PO + (size_t)(row0 + blk * 128 + (i & 1) * 64) * OD_N + 1024 + 64 * kvh;
                const unsigned toff = (unsigned)((tid_s >> 3) * OD_N + 8 * ch);
                float kf[8]; unpack8(*(const GAS u32x4*)(ub + toff), kf); const u32x4 vraw = *(const GAS u32x4*)(ub + 256 + toff);
                float ss = 0.f;
#pragma unroll
                for (int e = 0; e < 8; ++e) ss += kf[e] * kf[e];
                ss = reduce8(ss); const float rstd = 1.0f / sqrtf(ss * (1.f / 64.f) + 1e-6f);
#pragma unroll
                for (int e = 0; e < 8; ++e) kf[e] = kf[e] * rstd * (gk[8 * ch + e] * gqs[8 * ch + e]);
                *(LAS u32x4*)(lds + srel * AT_KSTR + ch * 16) = pack8(kf);
                *(LAS u32x4*)(lds + AT_VOFF + srel * AT_VSTR + ((ch ^ (4 * ((srel >> 1) & 1))) * 16)) = vraw; }
            else { *(LAS u32x4*)(lds + srel * AT_KSTR + ch * 16) = u32x4{0u, 0u, 0u, 0u}; *(LAS u32x4*)(lds + AT_VOFF + srel * AT_VSTR + ch * 16) = u32x4{0u, 0u, 0u, 0u}; } } }
    lds_barrier();
    if (!(AVAR & 2))
#pragma unroll
    for (int it = 0; it < 2; ++it) { const int item = wid + 8 * it, g = item >> 2, qi = item & 3, hh = 4 * kvh + g;
        const size_t qrow = (size_t)(t0 + 32 * qi + q);
        bf16x8 qf[4];
        { float qv[4][8]; float ss = 0.f;
#pragma unroll
            for (int ks = 0; ks < 4; ++ks) { unpack8(qraw[ks], qv[ks]);
#pragma unroll
                for (int e = 0; e < 8; ++e) ss += qv[ks][e] * qv[ks][e]; }
            ss += __shfl_xor(ss, 32); const float sc = (1.0f / sqrtf(ss * (1.f / 64.f) + 1e-6f)) * 0.125f * LOG2E;
#pragma unroll
            for (int ks = 0; ks < 4; ++ks) { float w[8];
#pragma unroll
                for (int e = 0; e < 8; ++e) w[e] = qv[ks][e] * sc;
                qf[ks] = __builtin_bit_cast(bf16x8, pack8(w)); } }
        u32x2 zpre[8];
        const float slope2 = exp2f(-0.5f * (float)(hh + 1)) * LOG2E;
        const float sinkv = a->in[I_ATSINK][j * 16 + hh]; float lpart = 0.0f;
        f32x16 o0, o1;
#pragma unroll
        for (int r = 0; r < 16; ++r) { o0[r] = 0.f; o1[r] = 0.f; }
        const float tq0 = (float)(q - 4 * hi);
        const float v0f = qb >= 1 ? 1.0f : 0.0f, v2f = qb + 1 < nb ? 1.0f : 0.0f;
        LAS unsigned char* kp = lds + (32 * qi + q) * AT_KSTR + hi * 16;
        LAS unsigned char* vp0; LAS unsigned char* vp1;
        { const int qq = (lane & 15) >> 2, pp = lane & 3, dsub = (lane >> 4) & 1, sw = (qq >> 1) & 1;
          LAS unsigned char* vb = lds + AT_VOFF + (32 * qi + 4 * hi + qq) * AT_VSTR + (2 * dsub + (pp >> 1)) * 16 + 8 * (pp & 1);
          vp0 = vb + 64 * sw; vp1 = vb + 64 * (1 - sw); }
        const f32x16 cinit = {0.f, 0.f, 0.f, 0.f, 0.f, 0.f, 0.f, 0.f, 0.f, 0.f, 0.f, 0.f, 0.f, 0.f, 0.f, 0.f};
        const float Apos = slope2 * tq0 - mref2, Aneg = -slope2 * tq0 - mref2;
        bf16x8 kf[4];
#define AT_LOADK(t) do { _Pragma("unroll") for (int ks = 0; ks < 4; ++ks) kf[ks] = *(const LAS bf16x8*)(kp + (t) * (32 * AT_KSTR) + 32 * ks); } while (0)
#define AT_QK(p) do { p = __builtin_amdgcn_mfma_f32_32x32x16_bf16(kf[0], qf[0], cinit, 0, 0, 0); p = __builtin_amdgcn_mfma_f32_32x32x16_bf16(kf[1], qf[1], p, 0, 0, 0); \
                      p = __builtin_amdgcn_mfma_f32_32x32x16_bf16(kf[2], qf[2], p, 0, 0, 0); p = __builtin_amdgcn_mfma_f32_32x32x16_bf16(kf[3], qf[3], p, 0, 0, 0); } while (0)
        f32x16 pc; AT_LOADK(0); AT_QK(pc); AT_LOADK(1);
#pragma unroll
        for (int t = 0; t < ((AVAR & 4) ? 0 : 9); ++t) { const int D = t - 4;
            u32x4 va[2][2];
#pragma unroll
            for (int s = 0; s < 2; ++s)
#pragma unroll
                for (int dh = 0; dh < 2; ++dh) { LAS unsigned char* vpp = (dh ? vp1 : vp0) + (32 * t + 16 * s) * AT_VSTR;
                    const u32x2 lo = __builtin_bit_cast(u32x2, __builtin_amdgcn_ds_read_tr16_b64_v4i16((LAS v4i16_t*)vpp)), hi2 = __builtin_bit_cast(u32x2, __builtin_amdgcn_ds_read_tr16_b64_v4i16((LAS v4i16_t*)(vpp + 8 * AT_VSTR)));
                    va[s][dh] = u32x4{lo.x, lo.y, hi2.x, hi2.y}; }
            f32x16 pn;
            if (t + 1 < 9) { AT_QK(pn); if (t + 2 < 9) AT_LOADK(t + 2); }
            if (t == 5) {
#pragma unroll
                for (int rg = 0; rg < 4; ++rg)
#pragma unroll
                    for (int dt = 0; dt < 2; ++dt) zpre[2 * rg + dt] = *(const GAS u32x2*)(PO + qrow * OD_N + 1536 + 64 * hh + 32 * dt + 8 * rg + 4 * hi); }
            if (t == 7) {
                if (it == 0) { const int item1 = wid + 8, g1 = item1 >> 2, hh1 = 4 * kvh + g1;
#pragma unroll
                    for (int ks = 0; ks < 4; ++ks) qraw[ks] = *(const GAS u32x4*)(PO + qrow * OD_N + 64 * hh1 + 16 * ks + 8 * hi); } }
            float ps = 0.f;
#pragma unroll
            for (int r = 0; r < 16; ++r) { const int cr = (r & 3) + 8 * (r >> 2); const float c = (float)(32 * D + cr);
                float e;
                if (D > 0) e = __builtin_amdgcn_exp2f(__builtin_fmaf(slope2, -c, pc[r] + Apos));
                else if (D < 0) e = __builtin_amdgcn_exp2f(__builtin_fmaf(slope2, c, pc[r] + Aneg));
                else e = __builtin_amdgcn_exp2f(__builtin_fmaf(-slope2, fabsf(tq0 - c), pc[r]) - mref2);
                if (D == -4) e = (float)cr >= tq0 ? e : 0.f;
                if (D == 4) e = (float)cr <= tq0 ? e : 0.f;
                pc[r] = e; ps += e; }
            { const int kbt = (qi + t) >> 2; const float vm = kbt == 0 ? v0f : (kbt == 2 ? v2f : 1.0f); lpart += ps * vm; }
#pragma unroll
            for (int s = 0; s < 2; ++s) { float w[8];
#pragma unroll
                for (int e = 0; e < 8; ++e) w[e] = pc[8 * s + e];
                const bf16x8 pf = __builtin_bit_cast(bf16x8, pack8(w));
                o0 = __builtin_amdgcn_mfma_f32_32x32x16_bf16(__builtin_bit_cast(bf16x8, va[s][0]), pf, o0, 0, 0, 0);
                o1 = __builtin_amdgcn_mfma_f32_32x32x16_bf16(__builtin_bit_cast(bf16x8, va[s][1]), pf, o1, 0, 0, 0); }
            if (t + 1 < 9) pc = pn;
            asm volatile("" : "+v"(o0), "+v"(o1));
            __builtin_amdgcn_sched_barrier(0);
        }
#undef AT_LOADK
#undef AT_QK
        const float ltot = lpart + __shfl_xor(lpart, 32) + __builtin_amdgcn_exp2f(sinkv * LOG2E - mref2); const float inv = 1.0f / ltot;
#pragma unroll
        for (int rg = 0; rg < 4; ++rg) {
#pragma unroll
            for (int dt = 0; dt < 2; ++dt) { const int d0 = 32 * dt + 8 * rg + 4 * hi;
                const u32x2 zw = zpre[2 * rg + dt];
                const float z0 = bflo(zw.x), z1 = bfhi(zw.x), z2 = bflo(zw.y), z3 = bfhi(zw.y);
                const float v0 = (dt == 0 ? o0[4 * rg + 0] : o1[4 * rg + 0]) * inv * siluf_(z0), v1 = (dt == 0 ? o0[4 * rg + 1] : o1[4 * rg + 1]) * inv * siluf_(z1);
                const float v2 = (dt == 0 ? o0[4 * rg + 2] : o1[4 * rg + 2]) * inv * siluf_(z2), v3 = (dt == 0 ? o0[4 * rg + 3] : o1[4 * rg + 3]) * inv * siluf_(z3);
                u32x2 w; w.x = pk2(v0, v1); w.y = pk2(v2, v3); *(GAS u32x2*)(MIX + qrow * 1024 + 64 * hh + d0) = w; } }
    }
    lds_barrier();
}

#define PH_PROLOG KArgs a = opaque(a0); unsigned char* ws = a->ws; int tid_ = wave_s * 64 + lane_id(); asm volatile("" : "+v"(tid_)); int bx_ = blockIdx.x; asm volatile("" : "+s"(bx_)); \
    const int tid = tid_, lane = tid & 63, wave = __builtin_amdgcn_readfirstlane(tid >> 6); \
    const int G = gridDim.x, bx = bx_, gw = bx * NWAVES + wave, NGW = G * NWAVES; const int j = layer >> 1; (void)ws; (void)lane; (void)gw; (void)NGW; (void)j; (void)tid; \
    const float* xb0 = layer == 0 ? a->in[I_XP] : a->out; const float* xb1 = layer == 0 ? a->in[I_XS] : a->out + (size_t)TP * DM; (void)xb0; (void)xb1;
#define WSP(off) ((bf16_t*)(ws + (off)))

__device__ __forceinline__ void ph_even_prep(KArgs a0, LAS unsigned char* lds, int layer, int wave_s) { PH_PROLOG
    LAS float* scr = (LAS float*)(lds + wave * 16384);
    const float* win = a->in[I_EVWIN] + (size_t)j * DM * 3200; const float* wout = a->in[I_EVWOUT] + (size_t)j * DM * DM; const float* wglu = a->in[I_S5GLUW] + (size_t)j * 512 * 512;
    bf16_t* WIN = WSP(WS_WIN);
    constexpr int I1 = 16 * 100, I2 = 16 * 32, I3 = 8 * 16;
    for (int it = gw; it < I1 + I2 + I3; it += NGW) { int r = it;
        if (r < I1) { transpose_item(win, DM, 3200, WIN, scr, r, lane); continue; } r -= I1;
        if (r < I2) { transpose_item(wout, DM, DM, WSP(WS_WOUT), scr, r, lane); continue; } r -= I2;
        transpose_item(wglu, 512, 512, WSP(WS_WGLU), scr, r, lane); }
    { unsigned z = 0u; asm volatile("" : "+v"(z));
      for (int e = bx * 512 + tid; e < 128 * 1024 / 8; e += G * 512) *(GAS u32x4*)(WIN + (size_t)3200 * DM + (size_t)e * 8) = (u32x4){z, z, z, z}; }
    { bf16_t* lo = WSP(WS_LORA); const float* aup = a->in[I_RWAUP] + (size_t)j * 64 * 512; const float* wup = a->in[I_RWWUP] + (size_t)j * 2 * 64 * 512;
      for (int e = bx * 512 + tid; e < 3 * 512 * 64; e += G * 512) { const int which = e >> 15, hc = (e >> 6) & 511, i = e & 63;
          lo[e] = (bf16_t)f2bf(which == 0 ? aup[(size_t)i * 512 + hc] : wup[((size_t)(which - 1) * 64 + i) * 512 + hc]); } }
    __syncthreads();
    const bool spread = G >= 256;
    if (spread ? bx < 128 : bx < 32) s5_prep_group(a, j, spread ? bx >> 2 : bx, spread ? bx & 3 : 0, lds, WSP(WS_BMAT), WSP(WS_W2), tid);
    if (!spread && bx < 32) { s5_prep_group(a, j, bx, 1, lds, WSP(WS_BMAT), WSP(WS_W2), tid); s5_prep_group(a, j, bx, 2, lds, WSP(WS_BMAT), WSP(WS_W2), tid); s5_prep_group(a, j, bx, 3, lds, WSP(WS_BMAT), WSP(WS_W2), tid); }
    constexpr int R1 = 15360;
    const float* gain = a->in[I_EVNORM] + j * DM; bf16_t* XN = WSP(WS_A);
    int m0, m1, w0, wn;
    if (spread) { if (bx < 128) { m0 = 0; m1 = R1; w0 = bx * NWAVES + wave; wn = 128 * NWAVES; } else { m0 = R1; m1 = T; w0 = (bx - 128) * NWAVES + wave; wn = (G - 128) * NWAVES; } }
    else { m0 = 0; m1 = T; w0 = gw; wn = NGW; }
    for (int m = m0 + 2 * w0; m < m1; m += 2 * wn) rms_rows2_to_bf16(m < TP ? xb0 + (size_t)m * DM : xb1 + (size_t)(m - TP) * DM, m + 1 < TP ? xb0 + (size_t)(m + 1) * DM : xb1 + (size_t)(m + 1 - TP) * DM, gain, XN + (size_t)m * DM, XN + (size_t)(m + 1) * DM, lane);
}
__device__ __forceinline__ void ph_even_inproj(KArgs a0, LAS unsigned char* lds, int layer, int wave_s) { PH_PROLOG
    pg8::Gemm g{WSP(WS_A), WSP(WS_WIN), DM, DM, DM}; pg8::StaticOrder S; S.init(T, EV_N, G, bx); pg8::EpiEvenIn E{WSP(WS_UH), WSP(WS_ZS5), WSP(WS_PRW)}; pg8::gemm_phase(lds, g, S, E, tid);
}
__device__ __forceinline__ void ph_s5_hend(KArgs a0, LAS unsigned char* lds, int layer, int wave_s) { PH_PROLOG
    pg8::Gemm g{WSP(WS_UH), WSP(WS_BMAT), 256, 512, 256}; pg8::GroupedOrder S; S.init(32 * NINST / 256, NINST / 256, G, bx); pg8::EpiBf16 E{WSP(WS_A), 256}; pg8::gemm_phase(lds, g, S, E, tid);
}
__device__ __forceinline__ void ph_s5_carry_a(KArgs a0, LAS unsigned char* lds, int layer, int wave_s) { PH_PROLOG
    for (int u = gw; u < 96 * 64; u += NGW) s5_carry_seg<false>(a, j, u, WSP(WS_A), (float*)(ws + WS_A + 48 * MiB), WSP(WS_UH), lane);
    for (int u = gw; u < SH_NSEG * 2; u += NGW) shift_save_halo(WSP(WS_PRW), WSP(WS_BMAT), u, lane);
}
__device__ __forceinline__ void ph_s5_carry_b(KArgs a0, LAS unsigned char* lds, int layer, int wave_s) { PH_PROLOG
    for (int u = gw; u < 96 * 64; u += NGW) s5_carry_seg<true>(a, j, u, WSP(WS_A), (float*)(ws + WS_A + 48 * MiB), WSP(WS_UH), lane);
    for (int u = gw; u < SH_NSEG * 4; u += NGW) shift_rows(a, j, WSP(WS_PRW), WSP(WS_BMAT), u, lane);
}
__device__ __forceinline__ void ph_s5_out(KArgs a0, LAS unsigned char* lds, int layer, int wave_s) { PH_PROLOG
    pg8::Gemm g{WSP(WS_UH), WSP(WS_W2), 512, 512, 512}; pg8::GroupedOrder S; S.init(32 * NINST / 256, NINST / 256, G, bx); pg8::EpiS5Out E{WSP(WS_A + 48 * MiB)}; pg8::gemm_phase(lds, g, S, E, tid);
}
__device__ __forceinline__ void ph_glu(KArgs a0, LAS unsigned char* lds, int layer, int wave_s) { PH_PROLOG
    pg8::Gemm g{WSP(WS_A + 48 * MiB), WSP(WS_WGLU), 512, 512, 512}; pg8::StaticOrder S; S.init(T, 512, G, bx);
    pg8::EpiGlu E{WSP(WS_A + 48 * MiB), WSP(WS_ZS5), a->in[I_S5GLUB] + j * 512, WSP(WS_UH)}; pg8::gemm_phase(lds, g, S, E, tid);
}
__device__ __forceinline__ void ph_rwkv_p1(KArgs a0, LAS unsigned char* lds, int layer, int wave_s) { PH_PROLOG
    for (int it = bx; it < rw::NSC * 8; it += G) rw::unit_pair<false>(a, j, it, lds, WSP(WS_PRW), WSP(WS_LORA), (float*)(ws + WS_A), (float*)(ws + WS_RWH), nullptr, nullptr, nullptr, nullptr, tid);
}
#ifdef PROBE_V
__device__ __forceinline__ void ph_rwkv_probe(KArgs a0, LAS unsigned char* lds, int layer, int wave_s) { PH_PROLOG
    for (int it = bx; it < rw::NSC * 8; it += G) rw::unit_pair<false, PROBE_V>(a, j, it, lds, WSP(WS_PRW), WSP(WS_LORA), (float*)(ws + WS_A), (float*)(ws + WS_RWH), nullptr, nullptr, nullptr, nullptr, tid);
}
#endif
__device__ __forceinline__ void ph_rwkv_p2(KArgs a0, LAS unsigned char* lds, int layer, int wave_s) { PH_PROLOG
    const bool split = G == 256;
    if (bx < 80) for (int c = bx; c < 80; c += G) rw::chain_states(c, lds, (const float*)(ws + WS_A), (float*)(ws + WS_RWH), tid);
    pg8::Gemm g{WSP(WS_A + 48 * MiB), WSP(WS_WGLU), 512, 512, 512}; pg8::SpanOrder S; S.init(T, 512, G, bx);
    if (!split) { S.base = bx; S.stride = G; S.cnt = (384 - bx + G - 1) / G; }
    else if (bx >= 80) { S.base = bx - 80; S.stride = 176; S.cnt = 2; }
    else { S.base = 352 + (bx - 16); S.stride = 0; S.cnt = (bx >= 16 && bx < 48) ? 1 : 0; }
    pg8::EpiGlu E{WSP(WS_A + 48 * MiB), WSP(WS_ZS5), a->in[I_S5GLUB] + j * 512, WSP(WS_UH)}; pg8::gemm_phase(lds, g, S, E, tid);
}
__device__ __forceinline__ void ph_rwkv_p3(KArgs a0, LAS unsigned char* lds, int layer, int wave_s) { PH_PROLOG
    for (int it = bx; it < rw::NSC * 8; it += G) rw::unit_pair<true>(a, j, it, lds, WSP(WS_PRW), WSP(WS_LORA), nullptr, (float*)(ws + WS_RWH), WSP(WS_A), WSP(WS_A + 48 * MiB), WSP(WS_ZS5), WSP(WS_UH), tid);
}
__device__ __forceinline__ void ph_outproj(KArgs a0, LAS unsigned char* lds, int layer, int wave_s, size_t mix_off) { PH_PROLOG
    pg8::Gemm g{WSP(mix_off), WSP(WS_WOUT), DM, DM, DM}; pg8::StaticOrder S; S.init(T, DM, G, bx); pg8::EpiRes E{xb0, xb1, a->out}; pg8::gemm_phase(lds, g, S, E, tid);
}
__device__ __forceinline__ void ph_odd_prep(KArgs a0, LAS unsigned char* lds, int layer, int wave_s) { PH_PROLOG
    LAS float* scr = (LAS float*)(lds + wave * 16384);
    const float* win = a->in[I_ODWIN] + (size_t)j * DM * OD_N; const float* wout = a->in[I_ODWOUT] + (size_t)j * DM * DM;
    constexpr int I1 = 16 * 80, I2 = 16 * 32;
    for (int it = gw; it < I1 + I2; it += NGW) { int r = it;
        if (r < I1) { transpose_item(win, DM, OD_N, WSP(WS_WIN), scr, r, lane); continue; } r -= I1;
        transpose_item(wout, DM, DM, WSP(WS_WOUT), scr, r, lane); }
    const float* gain = a->in[I_ODNORM] + j * DM; bf16_t* XN = WSP(WS_A);
    for (int m = 2 * gw; m < T; m += 2 * NGW) rms_rows2_to_bf16(xb0 + (size_t)m * DM, xb0 + (size_t)(m + 1) * DM, gain, XN + (size_t)m * DM, XN + (size_t)(m + 1) * DM, lane);
}
__device__ __forceinline__ void ph_odd_inproj(KArgs a0, LAS unsigned char* lds, int layer, int wave_s) { PH_PROLOG
    pg8::Gemm g{WSP(WS_A), WSP(WS_WIN), DM, DM, DM}; pg8::StaticOrder S; S.init(T, OD_N, G, bx); pg8::EpiBf16 E{WSP(WS_UH), OD_N}; pg8::gemm_phase(lds, g, S, E, tid);
}
#ifdef PROBE_A
__device__ __forceinline__ void ph_attn_probe(KArgs a0, LAS unsigned char* lds, int layer, int wave_s) { PH_PROLOG
    const float mref2 = attn_mref2(a, j);
    for (int u = bx; u < (T / 128) * 4; u += G) attn_unit<PROBE_A>(a, j, u, lds, WSP(WS_UH), WSP(WS_A), tid, mref2);
}
#endif
__device__ __forceinline__ void ph_attn(KArgs a0, LAS unsigned char* lds, int layer, int wave_s) { PH_PROLOG
    const float mref2 = attn_mref2(a, j);
    for (int u = bx; u < (T / 128) * 4; u += G) attn_unit(a, j, u, lds, WSP(WS_UH), WSP(WS_A), tid, mref2);
}

__global__ void __launch_bounds__(NWAVES * 64, 2) trunk_fwd(Args args) {
    extern __shared__ __attribute__((aligned(16))) unsigned char lds_raw[];
    LAS unsigned char* lds = (LAS unsigned char*)lds_raw;
    KArgs a0 = (KArgs)__builtin_amdgcn_kernarg_segment_ptr();
    const int wave_s = __builtin_amdgcn_readfirstlane((int)threadIdx.x >> 6);
    for (int u = wave_s * 64 + lane_id(); u < (LDS_BYTES - LDSCTL_OFF) / 4; u += NWAVES * 64) ((LAS unsigned*)(lds + LDSCTL_OFF))[u] = 0u;
    __syncthreads();
    (void)xcd_barrier_post((unsigned*)(a0->ws + WS_CTL) + CW_BAR, (volatile LAS unsigned*)(lds + MISC_OFF) + 8, wave_s == 0 && lane_id() == 0);
    const int ph_lo = a0->ph_lo, ph_hi = a0->ph_hi;
    int ph = 0;
#ifndef DUPM
#define DUPM 0u
#endif
#define GRID_BAR() do { KArgs ab = opaque(a0); XcdBarrier bar_; bar_.bar = (unsigned*)(ab->ws + WS_CTL) + CW_BAR; bar_.x = xb_xcc_id(); bar_.st = (volatile LAS unsigned*)(lds + MISC_OFF) + 8; xcd_barrier(bar_, wave_s); } while (0)
#define RUN_PHASE(call) do { if (ph >= ph_lo && ph < ph_hi) { call; if ((DUPM >> kind) & 1u) { GRID_BAR(); call; } if (ph + 1 < ph_hi) GRID_BAR(); } ++ph; ++kind; } while (0)
#define EVEN_LAYER(L) do { const int layer = (L); int kind = 0; (void)kind; \
            RUN_PHASE(ph_even_prep(a0, lds, layer, wave_s)); \
            RUN_PHASE(ph_even_inproj(a0, lds, layer, wave_s)); \
            RUN_PHASE(ph_s5_hend(a0, lds, layer, wave_s)); \
            RUN_PHASE(ph_s5_carry_a(a0, lds, layer, wave_s)); \
            RUN_PHASE(ph_s5_carry_b(a0, lds, layer, wave_s)); \
            RUN_PHASE(ph_s5_out(a0, lds, layer, wave_s)); \
            RUN_PHASE(ph_rwkv_p1(a0, lds, layer, wave_s)); \
            RUN_PHASE(ph_rwkv_p2(a0, lds, layer, wave_s)); \
            RUN_PHASE(ph_rwkv_p3(a0, lds, layer, wave_s)); \
            RUN_PHASE(ph_outproj(a0, lds, layer, wave_s, WS_UH)); } while (0)
#ifdef PROBE_A
#define ATTN_PROBE() do { ph_attn_probe(a0, lds, layer, wave_s); GRID_BAR(); } while (0)
#else
#define ATTN_PROBE() do {} while (0)
#endif
#define ODD_LAYER(L) do { const int layer = (L); int kind = 10; (void)kind; \
            RUN_PHASE(ph_odd_prep(a0, lds, layer, wave_s)); \
            RUN_PHASE(ph_odd_inproj(a0, lds, layer, wave_s)); \
            ATTN_PROBE(); RUN_PHASE(ph_attn(a0, lds, layer, wave_s)); \
            RUN_PHASE(ph_outproj(a0, lds, layer, wave_s, WS_A)); } while (0)
    EVEN_LAYER(0); ODD_LAYER(1); EVEN_LAYER(2); ODD_LAYER(3);
#undef EVEN_LAYER
#undef ODD_LAYER
#undef RUN_PHASE
}
constexpr int N_PHASES = 28;

extern "C" void kernel_launch(void* const* d_in, const int* in_sizes, int n_in, void* d_out, int out_size, void* d_ws, size_t ws_size, hipStream_t stream) {
    static int grid = 0;
    if (grid == 0) {
        if (n_in != 31 || out_size != T * DM || ws_size < WS_END) { fprintf(stderr, "kernel_launch: unexpected problem: n_in %d out %d ws %zu (need %zu)\n", n_in, out_size, ws_size, (size_t)WS_END); grid = -1; return; }
        int dev = 0, cus = 0, per_cu = 0;
        if (hipGetDevice(&dev) != hipSuccess || hipDeviceGetAttribute(&cus, hipDeviceAttributeMultiprocessorCount, dev) != hipSuccess) { grid = -1; return; }
        if (hipFuncSetAttribute((const void*)trunk_fwd, hipFuncAttributeMaxDynamicSharedMemorySize, LDS_BYTES) != hipSuccess) { fprintf(stderr, "kernel_launch: hipFuncSetAttribute failed\n"); grid = -1; return; }
        if (hipOccupancyMaxActiveBlocksPerMultiprocessor(&per_cu, (const void*)trunk_fwd, NWAVES * 64, LDS_BYTES) != hipSuccess || per_cu < 1) { fprintf(stderr, "kernel_launch: occupancy query says %d blocks per CU\n", per_cu); (void)hipGetLastError(); grid = -1; return; }
        grid = cus;
    }
    if (grid < 0) return;
    if (hipMemsetAsync((char*)d_ws + WS_CTL, 0, CTL_ZERO_BYTES, stream) != hipSuccess) return;
    Args a{};
    for (int i = 0; i < 31; ++i) a.in[i] = (const float*)d_in[i];
    a.out = (float*)d_out; a.ws = (unsigned char*)d_ws; a.ph_lo = 0; a.ph_hi = N_PHASES;
    hipLaunchKernelGGL(trunk_fwd, dim3(grid), dim3(NWAVES * 64), LDS_BYTES, stream, a);
}
```

```cpp
#include <hip/hip_runtime.h>
#include <cstdio>
#include <cstdint>

#define GAS __attribute__((address_space(1)))
#define LAS __attribute__((address_space(3)))
typedef unsigned short bf16_t;
typedef short bf16x8 __attribute__((ext_vector_type(8)));
typedef float f32x4 __attribute__((ext_vector_type(4)));
typedef float f32x2 __attribute__((ext_vector_type(2)));
typedef float f32x16 __attribute__((ext_vector_type(16)));
typedef unsigned u32x4 __attribute__((ext_vector_type(4)));
typedef unsigned u32x2 __attribute__((ext_vector_type(2)));
typedef __bf16 bf16x2_t __attribute__((ext_vector_type(2)));
typedef GAS unsigned gu32;
typedef short v4i16_t __attribute__((ext_vector_type(4)));

constexpr int T = 49152;
constexpr int TP = 32768;
constexpr int DM = 1024;
constexpr int NINST = T / 16;
constexpr int EV_N = 3328;
constexpr int PRW_LD = 2304;
constexpr int OD_N = 2560;

constexpr size_t MiB = 1u << 20;
constexpr size_t WS_CTL = 0, CTL_ZERO_BYTES = 32 * 1024;
constexpr size_t WS_WIN = 1 * MiB;
constexpr size_t WS_WOUT = 8 * MiB;
constexpr size_t WS_WGLU = 10 * MiB;
constexpr size_t WS_BMAT = 11 * MiB;
constexpr size_t WS_W2 = 15 * MiB;
constexpr size_t WS_A = 24 * MiB;
constexpr size_t WS_UH = 120 * MiB;
constexpr size_t WS_ZS5 = 216 * MiB;
constexpr size_t WS_PRW = 264 * MiB;
constexpr size_t WS_LORA = 23 * MiB;
constexpr size_t WS_RWH = 480 * MiB;
constexpr size_t WS_MIXO = 360 * MiB;
constexpr size_t WS_SSQ = 216 * MiB;
constexpr size_t WS_WOUT2 = 504 * MiB;
constexpr size_t WS_RSTD = 507 * MiB;
constexpr size_t WS_E = 508 * MiB;
constexpr size_t WS_PS = 604 * MiB;
constexpr size_t WS_YB = 628 * MiB;
constexpr size_t WS_BS = 676 * MiB;
constexpr size_t WS_END = 680 * MiB;

constexpr int CW_BAR = 4096;

__device__ __forceinline__ unsigned f2bf(float f) { unsigned u = __builtin_bit_cast(unsigned, f); return (u + 0x7fffu + ((u >> 16) & 1u)) >> 16; }
__device__ __forceinline__ unsigned pk2(float lo, float hi) { f32x2 v = {lo, hi}; bf16x2_t b = __builtin_convertvector(v, bf16x2_t); return __builtin_bit_cast(unsigned, b); }
__device__ __forceinline__ float bf2f(unsigned short u) { return __builtin_bit_cast(float, (unsigned)u << 16); }
__device__ __forceinline__ float bflo(unsigned u) { return __builtin_bit_cast(float, u << 16); }
__device__ __forceinline__ float bfhi(unsigned u) { return __builtin_bit_cast(float, u & 0xffff0000u); }
__device__ __forceinline__ float sigmoidf_(float v) { return __builtin_amdgcn_rcpf(1.0f + __expf(-v)); }
__device__ __forceinline__ float siluf_(float v) { return v * sigmoidf_(v); }
__device__ __forceinline__ float gelu_tanh(float x) { const float u = 0.7978845608028654f * (x + 0.044715f * x * x * x); return x * sigmoidf_(2.0f * u); }
template <int CTRL> __device__ __forceinline__ float dpp_f(float x) { return __builtin_bit_cast(float, __builtin_amdgcn_update_dpp(0, __builtin_bit_cast(int, x), CTRL, 0xf, 0xf, true)); }
__device__ __forceinline__ float wave_sum_fast(float x) {
    x += dpp_f<0xB1>(x); x += dpp_f<0x4E>(x); x += dpp_f<0x141>(x); x += dpp_f<0x140>(x);
    return (__builtin_bit_cast(float, __builtin_amdgcn_readlane(__builtin_bit_cast(int, x), 0)) + __builtin_bit_cast(float, __builtin_amdgcn_readlane(__builtin_bit_cast(int, x), 16)))
         + (__builtin_bit_cast(float, __builtin_amdgcn_readlane(__builtin_bit_cast(int, x), 32)) + __builtin_bit_cast(float, __builtin_amdgcn_readlane(__builtin_bit_cast(int, x), 48)));
}
__device__ __forceinline__ float reduce8(float x) { x += dpp_f<0xB1>(x); x += dpp_f<0x4E>(x); x += dpp_f<0x141>(x); return x; }
__device__ __forceinline__ void unpack8(const u32x4 w, float (&f)[8]) {
    f[0] = bflo(w.x); f[1] = bfhi(w.x); f[2] = bflo(w.y); f[3] = bfhi(w.y); f[4] = bflo(w.z); f[5] = bfhi(w.z); f[6] = bflo(w.w); f[7] = bfhi(w.w);
}
__device__ __forceinline__ u32x4 pack8(const float (&f)[8]) { u32x4 w; w.x = pk2(f[0], f[1]); w.y = pk2(f[2], f[3]); w.z = pk2(f[4], f[5]); w.w = pk2(f[6], f[7]); return w; }

namespace pg8 {
constexpr int BM = 256, BK = 64, HALF = 128, HTB = HALF * BK * 2, STAGE_BYTES = 8 * HTB, NXCD = 8, WGM = 8;
constexpr int RS_LDS_OFF = 8 * HTB + 1024;
__host__ __device__ __forceinline__ int lds_byte(int r, int c) { const int st = (r >> 4) * 2 + (c >> 5), rr = r & 15, cc = c & 31, ob = rr * 64 + cc * 2; return st * 1024 + (ob ^ (((ob >> 9) & 1) << 5)); }
__host__ __device__ __forceinline__ void stage_rc(int b, int& R, int& C) { const int st = b / 1024, sb = b % 1024, swz = sb ^ (((sb >> 9) & 1) << 5); R = (st >> 1) * 16 + swz / 64; C = (st & 1) * 32 + (swz % 64) / 2; }
__host__ __device__ __forceinline__ int perm32(int rho) { const int n = rho >> 4, i = rho & 15; return 8 * (i >> 2) + 4 * n + (i & 3); }

struct Unit { int pm, pn, pb; };
struct Gemm { const bf16_t* A; const bf16_t* Bt; int K, lda, ldb; };

struct StaticOrder {
    int nM, nN, nwg, G, c;
    __device__ void init(int M, int N, int G_, int c_) { nM = M / BM; nN = N / BM; nwg = nM * nN; G = G_; c = c_; }
    __device__ bool next(int i, Unit& u) const {
        const long L = (long)i * G + c; if (L >= nwg) return false;
        int wgid = (int)L; { const int q = nwg / NXCD, r = nwg % NXCD, xcd = wgid % NXCD, off = wgid / NXCD; wgid = (xcd < r ? xcd * (q + 1) : r * (q + 1) + (xcd - r) * q) + off; }
        const int nig = WGM * nN, gid = wgid / nig, fm = gid * WGM, gsz = (nM - fm) < WGM ? (nM - fm) : WGM;
        u.pm = fm + ((wgid % nig) % gsz); u.pn = (wgid % nig) / gsz; u.pb = u.pn; return true;
    }
};
struct SpanOrder : StaticOrder {
    int base, stride, cnt;
    __device__ bool next(int i, Unit& u) const { if (i >= cnt) return false; StaticOrder t = *this; t.G = 1; t.c = base + i * stride; return t.StaticOrder::next(0, u); }
};
struct GroupedOrder {
    int nM, per, G, c;
    __device__ void init(int nM_, int per_, int G_, int c_) { nM = nM_; per = per_; G = G_; c = c_; }
    __device__ bool next(int i, Unit& u) const { const int L = i * G + c; if (L >= nM) return false; u.pm = L; u.pn = 0; u.pb = L / per; return true; }
};

struct EpiBf16 {
    static constexpr bool PERM = true; static constexpr bool ROWSCALE = false;
    bf16_t* O; int ldc;
    __device__ __forceinline__ void operator()(const f32x4 (&acc)[2][2][4][2], const Unit& u, int wr, int wc, int fr, int fq) const { float sc[2][4];
#pragma unroll
        for (int ai = 0; ai < 2; ++ai)
#pragma unroll
            for (int m = 0; m < 4; ++m) sc[ai][m] = 1.0f;
        scaled(acc, u, wr, wc, fr, fq, sc); }
    __device__ __forceinline__ void scaled(const f32x4 (&acc)[2][2][4][2], const Unit& u, int wr, int wc, int fr, int fq, const float (&sc)[2][4]) const {
        const int row0 = u.pm * BM + wr * 64 + fr, col0 = u.pn * BM + wc * 32 + 8 * fq;
#pragma unroll
        for (int ai = 0; ai < 2; ++ai)
#pragma unroll
            for (int m = 0; m < 4; ++m) { bf16_t* rowp = O + (size_t)(row0 + ai * HALF + m * 16) * ldc + col0;
#pragma unroll
                for (int bj = 0; bj < 2; ++bj) { const f32x4 v0 = acc[ai][bj][m][0] * sc[ai][m], v1 = acc[ai][bj][m][1] * sc[ai][m];
                    u32x4 w; w.x = pk2(v0[0], v0[1]); w.y = pk2(v0[2], v0[3]); w.z = pk2(v1[0], v1[1]); w.w = pk2(v1[2], v1[3]);
                    *(u32x4*)(rowp + bj * HALF) = w; } }
    }
};
struct EpiBf16S : EpiBf16 { static constexpr bool ROWSCALE = true; const float* rs; };
struct EpiEvenIn {
    static constexpr bool PERM = true;
    static constexpr bool ROWSCALE = true;
    bf16_t* UH; bf16_t* ZS5; bf16_t* PRW; const float* rs;
    __device__ __forceinline__ void scaled(const f32x4 (&acc)[2][2][4][2], const Unit& u, int wr, int wc, int fr, int fq, const float (&sc)[2][4]) const {
        const int row0 = u.pm * BM + wr * 64 + fr, col0 = u.pn * BM + wc * 32 + 8 * fq;
#pragma unroll
        for (int ai = 0; ai < 2; ++ai)
#pragma unroll
            for (int m = 0; m < 4; ++m) { const int row = row0 + ai * HALF + m * 16;
#pragma unroll
                for (int bj = 0; bj < 2; ++bj) { const f32x4 v0 = acc[ai][bj][m][0] * sc[ai][m], v1 = acc[ai][bj][m][1] * sc[ai][m]; const int col = col0 + bj * HALF;
                    u32x4 w; w.x = pk2(v0[0], v0[1]); w.y = pk2(v0[2], v0[3]); w.z = pk2(v1[0], v1[1]); w.w = pk2(v1[2], v1[3]);
                    bf16_t* p;
                    if (u.pn < 2) p = UH + ((size_t)((col >> 4) * NINST + (row >> 4)) * 512 + (row & 15) * 16 + (col & 15));
                    else if (u.pn < 4) p = ZS5 + (size_t)row * 512 + (col - 512);
                    else p = PRW + (size_t)row * PRW_LD + (col - 1024);
                    *(u32x4*)p = w; } }
    }
};
struct EpiS5Out {
    static constexpr bool ROWSCALE = false;
    static constexpr bool PERM = true;
    bf16_t* YG;
    __device__ __forceinline__ void operator()(const f32x4 (&acc)[2][2][4][2], const Unit& u, int wr, int wc, int fr, int fq) const {
        const int row0 = u.pm * BM + wr * 64 + fr, col0 = wc * 32 + 8 * fq;
#pragma unroll
        for (int ai = 0; ai < 2; ++ai)
#pragma unroll
            for (int m = 0; m < 4; ++m) { const int row = row0 + ai * HALF + m * 16; const int g = row / NINST, inst = row - g * NINST;
#pragma unroll
                for (int bj = 0; bj < 2; ++bj) { const f32x4 v0 = acc[ai][bj][m][0], v1 = acc[ai][bj][m][1]; const int col = col0 + bj * HALF;
                    u32x4 w; w.x = pk2(gelu_tanh(v0[0]), gelu_tanh(v0[1])); w.y = pk2(gelu_tanh(v0[2]), gelu_tanh(v0[3])); w.z = pk2(gelu_tanh(v1[0]), gelu_tanh(v1[1])); w.w = pk2(gelu_tanh(v1[2]), gelu_tanh(v1[3]));
                    *(u32x4*)(YG + (size_t)(inst * 16 + (col >> 4)) * 512 + g * 16 + (col & 15)) = w; } }
    }
};
struct EpiGlu {
    static constexpr bool ROWSCALE = false;
    static constexpr bool PERM = true;
    const bf16_t* YG; const bf16_t* ZS5; const float* bias; bf16_t* MIX;
    __device__ __forceinline__ void operator()(const f32x4 (&acc)[2][2][4][2], const Unit& u, int wr, int wc, int fr, int fq) const {
        const int row0 = u.pm * BM + wr * 64 + fr, col0 = u.pn * BM + wc * 32 + 8 * fq;
#pragma unroll
        for (int bj = 0; bj < 2; ++bj) { const int col = col0 + bj * HALF;
            const f32x4 b0 = *(const f32x4*)(bias + col), b1 = *(const f32x4*)(bias + col + 4);
#pragma unroll
            for (int ai = 0; ai < 2; ++ai)
#pragma unroll
                for (int m = 0; m < 4; ++m) { const int row = row0 + ai * HALF + m * 16;
                    const f32x4 v0 = acc[ai][bj][m][0] + b0, v1 = acc[ai][bj][m][1] + b1;
                    float yg[8], z[8], o[8]; unpack8(*(const u32x4*)(YG + (size_t)row * 512 + col), yg); unpack8(*(const u32x4*)(ZS5 + (size_t)row * 512 + col), z);
#pragma unroll
                    for (int i = 0; i < 4; ++i) { o[i] = yg[i] * sigmoidf_(v0[i]) * siluf_(z[i]); o[4 + i] = yg[4 + i] * sigmoidf_(v1[i]) * siluf_(z[4 + i]); }
                    *(u32x4*)(MIX + (size_t)row * 1024 + col) = pack8(o); } }
    }
};
struct EpiRes {
    static constexpr bool ROWSCALE = false;
    static constexpr bool PERM = true;
    const float* b0; const float* b1; const bf16_t* XRin; float* out; bf16_t* XR; float* SSQ;
    __device__ __forceinline__ void emit(const f32x4 o0, const f32x4 o1, int row, int col, float& ss) const {
        if (out) { float* op = out + (size_t)row * DM + col; *(f32x4*)op = o0; *(f32x4*)(op + 4) = o1; }
        else { ss += ((o0[0] * o0[0] + o0[1] * o0[1]) + (o0[2] * o0[2] + o0[3] * o0[3])) + ((o1[0] * o1[0] + o1[1] * o1[1]) + (o1[2] * o1[2] + o1[3] * o1[3]));
            u32x4 w; w.x = pk2(o0[0], o0[1]); w.y = pk2(o0[2], o0[3]); w.z = pk2(o1[0], o1[1]); w.w = pk2(o1[2], o1[3]); *(u32x4*)(XR + (size_t)row * DM + col) = w; } }
    __device__ __forceinline__ void operator()(const f32x4 (&acc)[2][2][4][2], const Unit& u, int wr, int wc, int fr, int fq) const {
        const int row0 = u.pm * BM + wr * 64 + fr, col0 = u.pn * BM + wc * 32 + 8 * fq;
        if (b0) {
#pragma unroll
            for (int ai = 0; ai < 2; ++ai) { f32x4 pre[4][2][2];
#pragma unroll
                for (int m = 0; m < 4; ++m) { const int row = row0 + ai * HALF + m * 16; const float* bp = (row < TP ? b0 + (size_t)row * DM : b1 + (size_t)(row - TP) * DM) + col0;
#pragma unroll
                    for (int bj = 0; bj < 2; ++bj)
#pragma unroll
                        for (int n = 0; n < 2; ++n) pre[m][bj][n] = *(const f32x4*)(bp + bj * HALF + n * 4); }
#pragma unroll
                for (int m = 0; m < 4; ++m) { const int row = row0 + ai * HALF + m * 16; float ss = 0.f;
#pragma unroll
                    for (int bj = 0; bj < 2; ++bj) emit(pre[m][bj][0] + acc[ai][bj][m][0], pre[m][bj][1] + acc[ai][bj][m][1], row, col0 + bj * HALF, ss);
                    if (!out) SSQ[(size_t)row * 64 + 16 * u.pn + 4 * wc + fq] = ss; }
                asm volatile("" ::: "memory"); }
        } else {
            u32x4 pre[2][4][2];
#pragma unroll
            for (int ai = 0; ai < 2; ++ai)
#pragma unroll
                for (int m = 0; m < 4; ++m)
#pragma unroll
                    for (int bj = 0; bj < 2; ++bj) pre[ai][m][bj] = *(const u32x4*)(XRin + (size_t)(row0 + ai * HALF + m * 16) * DM + col0 + bj * HALF);
#pragma unroll
            for (int ai = 0; ai < 2; ++ai)
#pragma unroll
                for (int m = 0; m < 4; ++m) { const int row = row0 + ai * HALF + m * 16; float ss = 0.f;
#pragma unroll
                    for (int bj = 0; bj < 2; ++bj) { float b[8]; unpack8(pre[ai][m][bj], b);
                        const f32x4 o0 = (f32x4){b[0], b[1], b[2], b[3]} + acc[ai][bj][m][0], o1 = (f32x4){b[4], b[5], b[6], b[7]} + acc[ai][bj][m][1];
                        emit(o0, o1, row, col0 + bj * HALF, ss); }
                    if (!out) SSQ[(size_t)row * 64 + 16 * u.pn + 4 * wc + fq] = ss; }
        }
    }
};

template <class Epi, class Sched>
__device__ __forceinline__ void gemm_phase(LAS unsigned char* lds, const Gemm g, const Sched& S, const Epi& E, const int tid) {
    const int wid = __builtin_amdgcn_readfirstlane(tid >> 6), lane = tid & 63, wr = wid >> 2, wc = wid & 3, fr = lane & 15, fq = lane >> 4;
    const int K = g.K, nt = K / BK;
    unsigned voffA[2], voffB[2];
#pragma unroll
    for (int i = 0; i < 2; ++i) { int R, C; stage_rc(tid * 16 + i * 8192, R, C); const int Rb = Epi::PERM ? ((R & ~31) + perm32(R & 31)) : R;
        voffA[i] = (unsigned)(R * g.lda + C) * 2u; voffB[i] = (unsigned)(Rb * g.ldb + C) * 2u; }
    const size_t kstep = (size_t)(BK * 2);
    const size_t hstepA = (size_t)HALF * g.lda * 2, hstepB = (size_t)HALF * g.ldb * 2;
    const size_t tstepA = 2 * hstepA, tstepB = 2 * hstepB;
    const unsigned ldsw = (unsigned)wid * 1024u;
    const int aoff = lds_byte(wr * 64 + fr, fq * 8), boff = lds_byte(wc * 32 + fr, fq * 8);
#define PG8_SA(b, h) (((b) * 2 + (h)) * HTB)
#define PG8_SB(b, h) ((4 + (b) * 2 + (h)) * HTB)
#define PG8_STAGE(bufoff, gbase, voff) do { _Pragma("unroll") for (int _i = 0; _i < 2; ++_i) \
        __builtin_amdgcn_global_load_lds((const unsigned*)((const char*)(gbase) + (voff)[_i]), (LAS unsigned*)(lds + (bufoff) + ldsw + _i * 8192), 16, 0, 0); } while (0)
#define PG8_LDA(dst, b, h) do { _Pragma("unroll") for (int m = 0; m < 4; ++m) _Pragma("unroll") for (int k = 0; k < 2; ++k) dst[m][k] = *(const LAS bf16x8*)(lds + PG8_SA(b, h) + aoff + m * 2048 + k * 1024); } while (0)
#define PG8_LDB(dst, b, h) do { _Pragma("unroll") for (int n = 0; n < 2; ++n) _Pragma("unroll") for (int k = 0; k < 2; ++k) dst[n][k] = *(const LAS bf16x8*)(lds + PG8_SB(b, h) + boff + n * 2048 + k * 1024); } while (0)
#define PG8_MMA(ai, bj, At, Bt) do { __builtin_amdgcn_s_setprio(1); _Pragma("unroll") for (int m = 0; m < 4; ++m) _Pragma("unroll") for (int n = 0; n < 2; ++n) _Pragma("unroll") for (int k = 0; k < 2; ++k) \
        acc[ai][bj][m][n] = __builtin_amdgcn_mfma_f32_16x16x32_bf16(Bt[n][k], At[m][k], acc[ai][bj][m][n], 0, 0, 0); __builtin_amdgcn_s_setprio(0); } while (0)
#define PG8_WAIT_V(n) asm volatile("s_waitcnt vmcnt(" #n ")" ::: "memory")
#define PG8_WAIT_L(n) asm volatile("s_waitcnt lgkmcnt(" #n ")" ::: "memory")
#define PG8_BAR __builtin_amdgcn_s_barrier()
#define PG8_SCHED __builtin_amdgcn_sched_barrier(0)
    Unit cur, nxt; int ui = 0;
    if (!S.next(0, cur)) return;
#define PG8_RS(unit_, par_) do { if constexpr (Epi::ROWSCALE) { if (wid < 4) __builtin_amdgcn_global_load_lds((const unsigned*)(E.rs + (size_t)(unit_).pm * BM + wid * 64 + lane), (LAS unsigned*)(lds + RS_LDS_OFF + (par_) * 1024 + wid * 256), 4, 0, 0); } } while (0)
    PG8_RS(cur, 0);
    f32x4 acc[2][2][4][2];
#pragma unroll
    for (int a = 0; a < 2; ++a)
#pragma unroll
        for (int b = 0; b < 2; ++b)
#pragma unroll
            for (int m = 0; m < 4; ++m)
#pragma unroll
                for (int n = 0; n < 2; ++n) acc[a][b][m][n] = (f32x4){0.f, 0.f, 0.f, 0.f};
    bf16x8 At[4][2], B0[2][2], B1[2][2];
    const char* cA = (const char*)g.A + (size_t)cur.pm * tstepA; const char* cB = (const char*)g.Bt + (size_t)cur.pb * tstepB;
    PG8_STAGE(PG8_SB(0, 0), cB, voffB); PG8_STAGE(PG8_SB(0, 1), cB + hstepB, voffB); PG8_STAGE(PG8_SA(0, 0), cA, voffA); PG8_STAGE(PG8_SA(0, 1), cA + hstepA, voffA);
    if (wr == 1) PG8_BAR;
    PG8_WAIT_V(2); PG8_BAR;
    PG8_STAGE(PG8_SB(1, 0), cB + kstep, voffB); PG8_STAGE(PG8_SA(1, 0), cA + kstep, voffA); PG8_STAGE(PG8_SB(1, 1), cB + hstepB + kstep, voffB);
    PG8_WAIT_V(0); PG8_BAR;
    for (;;) {
        const bool has_next = S.next(ui + 1, nxt);
        const char* nA = has_next ? (const char*)g.A + (size_t)nxt.pm * tstepA : cA; const char* nB = has_next ? (const char*)g.Bt + (size_t)nxt.pb * tstepB : cB;
#pragma unroll 1
        for (int t = 0; t < nt; t += 2) {
            const bool last = (t == nt - 2);
            const char* a1 = cA + (size_t)(t + 1) * kstep;
            const char* a2 = last ? nA : cA + (size_t)(t + 2) * kstep; const char* b2 = last ? nB : cB + (size_t)(t + 2) * kstep;
            const char* a3 = a2 + kstep; const char* b3 = b2 + kstep;
            PG8_LDB(B0, 0, 0); PG8_LDB(B1, 0, 1); PG8_SCHED; PG8_LDA(At, 0, 0); PG8_STAGE(PG8_SA(1, 1), a1 + hstepA, voffA);
            if (t) PG8_WAIT_V(8); PG8_WAIT_L(0); PG8_BAR; PG8_MMA(0, 0, At, B0); PG8_MMA(0, 1, At, B1); PG8_BAR; PG8_SCHED;
            PG8_LDA(At, 0, 1); PG8_STAGE(PG8_SB(0, 0), b2, voffB); PG8_STAGE(PG8_SB(0, 1), b2 + hstepB, voffB); PG8_STAGE(PG8_SA(0, 0), a2, voffA);
            if (t) PG8_WAIT_V(8); PG8_WAIT_L(0); PG8_BAR; PG8_MMA(1, 0, At, B0); PG8_MMA(1, 1, At, B1); PG8_BAR; PG8_SCHED;
            PG8_LDB(B0, 1, 0); PG8_LDB(B1, 1, 1); PG8_SCHED; PG8_LDA(At, 1, 0); PG8_STAGE(PG8_SA(0, 1), a2 + hstepA, voffA);
            PG8_WAIT_V(8); PG8_WAIT_L(0); PG8_BAR; PG8_MMA(0, 0, At, B0); PG8_MMA(0, 1, At, B1); PG8_BAR; PG8_SCHED;
            PG8_LDA(At, 1, 1); PG8_STAGE(PG8_SB(1, 0), b3, voffB); PG8_STAGE(PG8_SB(1, 1), b3 + hstepB, voffB); PG8_STAGE(PG8_SA(1, 0), a3, voffA);
            PG8_WAIT_V(8); PG8_WAIT_L(0); PG8_BAR; PG8_MMA(1, 0, At, B0); PG8_MMA(1, 1, At, B1); PG8_BAR; PG8_SCHED;
        }
        PG8_WAIT_V(0);
        if (wr == 0) PG8_BAR;
        if constexpr (Epi::ROWSCALE) { float sc[2][4];
#pragma unroll
            for (int ai = 0; ai < 2; ++ai)
#pragma unroll
                for (int m = 0; m < 4; ++m) sc[ai][m] = *(const LAS float*)(lds + RS_LDS_OFF + (ui & 1) * 1024 + (wr * 64 + fr + ai * HALF + m * 16) * 4);
            E.scaled(acc, cur, wr, wc, fr, fq, sc); }
        else E(acc, cur, wr, wc, fr, fq);
        if (!has_next) break;
        PG8_RS(nxt, (ui + 1) & 1);
#pragma unroll
        for (int a = 0; a < 2; ++a)
#pragma unroll
            for (int b = 0; b < 2; ++b)
#pragma unroll
                for (int m = 0; m < 4; ++m)
#pragma unroll
                    for (int n = 0; n < 2; ++n) acc[a][b][m][n] = (f32x4){0.f, 0.f, 0.f, 0.f};
        cur = nxt; cA = nA; cB = nB; ++ui;
        if (wr == 1) PG8_BAR;
    }
    PG8_WAIT_V(0);
    PG8_BAR;
#undef PG8_SA
#undef PG8_SB
#undef PG8_STAGE
#undef PG8_LDA
#undef PG8_LDB
#undef PG8_MMA
#undef PG8_WAIT_V
#undef PG8_WAIT_L
#undef PG8_BAR
#undef PG8_SCHED
#undef PG8_RS
}
}

__device__ __forceinline__ int lane_id() { int l; asm volatile("v_mbcnt_lo_u32_b32 %0, -1, 0\n\tv_mbcnt_hi_u32_b32 %0, -1, %0" : "=v"(l)); return l; }
#define RLX_AGENT __ATOMIC_RELAXED, __HIP_MEMORY_SCOPE_AGENT
#define XB_TMO      128
#define XB_XCNT(j)  (256  + 64 * (j))
#define XB_XSUB(j)  (1280 + 64 * (j))
#define XB_XGEN(j)  (2304 + 64 * (j))
#define XB_TOP      3328
#define XB_TOPGEN   3392
#define XCD_BAR_WORDS 3456
#define XB_SPIN_CAP (1u << 22)
__device__ __forceinline__ unsigned xb_ld(unsigned* p)              { return __hip_atomic_load(p, __ATOMIC_RELAXED, __HIP_MEMORY_SCOPE_AGENT); }
__device__ __forceinline__ unsigned xb_add(unsigned* p, unsigned v) { return __hip_atomic_fetch_add(p, v, __ATOMIC_RELAXED, __HIP_MEMORY_SCOPE_AGENT); }
__device__ __forceinline__ unsigned xb_xcc_id() { return (unsigned)__builtin_amdgcn_s_getreg((3 << 11) | 20) & 0xFu; }
#define XB_SPIN(cond, bar) do { unsigned _sp = 0; while (cond) { __builtin_amdgcn_s_sleep(1); \
    if ((++_sp & 255u) == 0u) { if (xb_ld(&(bar)[XB_TMO])) break; if (_sp > XB_SPIN_CAP) { atomicAdd(&(bar)[XB_TMO], 1u); break; } } } } while (0)
struct XcdBarrier { unsigned* bar; unsigned x; volatile LAS unsigned* st; };
__device__ __forceinline__ XcdBarrier xcd_barrier_post(unsigned* bar, volatile LAS unsigned* st, bool leader) {
    XcdBarrier b; b.bar = bar; b.x = xb_xcc_id(); b.st = st;
    if (leader) (void)xb_add(&bar[XB_XCNT(b.x)], 1u);
    return b;
}
__device__ __forceinline__ void xcd_barrier_complete(unsigned* bar, unsigned x, unsigned& nloc, unsigned& nx) {
    const unsigned G = gridDim.x * gridDim.y * gridDim.z;
    unsigned sum, cnt, mine, sp = 0u;
    for (;;) {
        sum = 0u; cnt = 0u; mine = 0u;
#pragma unroll
        for (unsigned j = 0; j < 16; ++j) { const unsigned c = xb_ld(&bar[XB_XCNT(j)]); sum += c; cnt += (c > 0u) ? 1u : 0u; mine = (j == x) ? c : mine; }
        if (sum == G) break;
        __builtin_amdgcn_s_sleep(1);
        if ((++sp & 255u) == 0u) { if (xb_ld(&bar[XB_TMO])) break; if (sp > XB_SPIN_CAP) { atomicAdd(&bar[XB_TMO], 1u); break; } }
    }
    nloc = mine > 0u ? mine : 1u; nx = cnt > 0u ? cnt : 1u;
}
__device__ __forceinline__ void xcd_barrier(const XcdBarrier& b, int wave_s) {
    asm volatile("s_waitcnt vmcnt(0)" ::: "memory");
    __syncthreads();
    if (wave_s == 0 && lane_id() == 0) {
        unsigned* bar = b.bar;
        __builtin_amdgcn_s_waitcnt(0);
        unsigned nloc = b.st[0], nx = b.st[1];
        if (nloc == 0u) { xcd_barrier_complete(bar, b.x, nloc, nx); b.st[0] = nloc; b.st[1] = nx; }
        const unsigned old = xb_add(&bar[XB_XSUB(b.x)], 1u);
        const unsigned gen = old / nloc;
        if (old + 1u == (gen + 1u) * nloc) {
            __builtin_amdgcn_fence(__ATOMIC_RELEASE, "agent");
            asm volatile("s_waitcnt vmcnt(0)" ::: "memory");
            const unsigned og = xb_add(&bar[XB_TOP], 1u);
            const unsigned tg = og / nx;
            if (og + 1u == (tg + 1u) * nx) xb_add(&bar[XB_TOPGEN], 1u);
            else XB_SPIN(xb_ld(&bar[XB_TOPGEN]) == tg, bar);
            __builtin_amdgcn_fence(__ATOMIC_ACQUIRE, "agent");
            xb_add(&bar[XB_XGEN(b.x)], 1u);
            asm volatile("s_waitcnt vmcnt(0)" ::: "memory");
        } else {
            XB_SPIN(xb_ld(&bar[XB_XGEN(b.x)]) == gen, bar);
            __builtin_amdgcn_fence(__ATOMIC_ACQUIRE, "agent");
            asm volatile("s_waitcnt vmcnt(0)" ::: "memory");
        }
    }
    __syncthreads();
}

constexpr int NWAVES = 8;
constexpr int RING_BYTES = 131072;
constexpr int LDSCTL_OFF = RING_BYTES, MISC_OFF = LDSCTL_OFF + 320;
constexpr int LDS_BYTES = 147456;
struct Args { const float* in[31]; float* out; unsigned char* ws; int ph_lo, ph_hi; };
typedef const __attribute__((address_space(4))) Args* KArgs;
__device__ __forceinline__ KArgs opaque(KArgs p) { unsigned long long v = (unsigned long long)p; asm volatile("" : "+s"(v)); return (KArgs)v; }
enum { I_XP = 0, I_XS, I_EVNORM, I_EVWIN, I_S5ARE, I_S5AIM, I_S5LOGDT, I_S5BRE, I_S5BIM, I_S5CRE, I_S5CIM, I_S5D, I_S5GLUW, I_S5GLUB, I_RWMU, I_RWW0, I_RWWUP, I_RWA0, I_RWAUP,
       I_RWKK, I_RWKA, I_RWRK, I_RWLNG, I_RWLNB, I_EVWOUT, I_ODNORM, I_ODWIN, I_ATQN, I_ATKN, I_ATSINK, I_ODWOUT };

__device__ __forceinline__ void transpose_item(const float* W, int K, int N, bf16_t* WT, LAS float* scr, int item, int lane, const float* gain = nullptr) {
    const int nblk = N / 32, kb = item / nblk, nb = item % nblk, k0 = 64 * kb, n0 = 32 * nb;
    float wv[32];
#pragma unroll
    for (int i = 0; i < 32; ++i) { const int kk = 2 * i + (lane >> 5); wv[i] = W[(size_t)(k0 + kk) * N + n0 + (lane & 31)]; }
#pragma unroll
    for (int i = 0; i < 32; ++i) { const int kk = 2 * i + (lane >> 5); const float gv = gain ? gain[k0 + kk] : 1.0f; scr[kk * 33 + (lane & 31)] = wv[i] * gv; }
    asm volatile("s_waitcnt lgkmcnt(0)" ::: "memory");
    const int c = lane & 7;
#pragma unroll
    for (int j = 0; j < 4; ++j) { const int n = (lane >> 3) + 8 * j; const LAS float* s = scr + (8 * c) * 33 + n;
        u32x4 o; o.x = pk2(s[0 * 33], s[1 * 33]); o.y = pk2(s[2 * 33], s[3 * 33]); o.z = pk2(s[4 * 33], s[5 * 33]); o.w = pk2(s[6 * 33], s[7 * 33]);
        *(GAS u32x4*)(WT + (size_t)(n0 + n) * K + k0 + 8 * c) = o; }
    asm volatile("s_waitcnt lgkmcnt(0)" ::: "memory");
}

__device__ __forceinline__ void raw_rows2_to_bf16(const float* xrow0, const float* xrow1, bf16_t* orow0, bf16_t* orow1, float* rstd0, float* rstd1, int lane) {
    const GAS f32x4* xr0 = (const GAS f32x4*)xrow0 + lane; const GAS f32x4* xr1 = (const GAS f32x4*)xrow1 + lane;
    f32x4 v0[4], v1[4]; float s0 = 0.f, s1 = 0.f;
#pragma unroll
    for (int j = 0; j < 4; ++j) { v0[j] = xr0[64 * j]; v1[j] = xr1[64 * j]; }
#pragma unroll
    for (int j = 0; j < 4; ++j) { s0 += (v0[j].x * v0[j].x + v0[j].y * v0[j].y) + (v0[j].z * v0[j].z + v0[j].w * v0[j].w); s1 += (v1[j].x * v1[j].x + v1[j].y * v1[j].y) + (v1[j].z * v1[j].z + v1[j].w * v1[j].w); }
    const float r0 = 1.0f / sqrtf(wave_sum_fast(s0) * (1.f / DM) + 1e-6f), r1 = 1.0f / sqrtf(wave_sum_fast(s1) * (1.f / DM) + 1e-6f);
    if (lane == 0) { *rstd0 = r0; *rstd1 = r1; }
    GAS u32x2* o0 = (GAS u32x2*)orow0 + lane; GAS u32x2* o1 = (GAS u32x2*)orow1 + lane;
#pragma unroll
    for (int j = 0; j < 4; ++j) { u32x2 w;
        w.x = pk2(v0[j].x, v0[j].y); w.y = pk2(v0[j].z, v0[j].w); o0[64 * j] = w;
        w.x = pk2(v1[j].x, v1[j].y); w.y = pk2(v1[j].z, v1[j].w); o1[64 * j] = w; }
}
__device__ __forceinline__ void rstd_from_ssq(const float* SSQ, float* RSTD, int t0, int tstep) {
    const int sub = t0 & 15;
    for (int row = t0 >> 4; row < T; row += tstep >> 4) { const f32x4 a = *(const GAS f32x4*)(SSQ + (size_t)row * 64 + 4 * sub);
        float ssum = (a[0] + a[1]) + (a[2] + a[3]); ssum += dpp_f<0xB1>(ssum); ssum += dpp_f<0x4E>(ssum); ssum += dpp_f<0x141>(ssum); ssum += dpp_f<0x140>(ssum);
        if (sub == 0) RSTD[row] = 1.0f / sqrtf(ssum * (1.f / DM) + 1e-6f); }
}

__device__ __forceinline__ void s5_prep_group(KArgs a, int j, int g, int part, LAS unsigned char* lds, bf16_t* Bmat, bf16_t* W2, const int tid) {
    LAS f32x2* pw = (LAS f32x2*)lds;
    LAS f32x2* bb = pw + 2 * 17 * 64;
    LAS f32x2* cc = bb + 2 * 64 * 16;
    LAS float* Kl = (LAS float*)(cc + 2 * 16 * 64);
    LAS float* Dg = Kl + 2 * 16 * 256;
    const float* a_re = a->in[I_S5ARE]; const float* a_im = a->in[I_S5AIM]; const float* log_dt = a->in[I_S5LOGDT];
    const float* b_re = a->in[I_S5BRE]; const float* b_im = a->in[I_S5BIM]; const float* c_re = a->in[I_S5CRE]; const float* c_im = a->in[I_S5CIM];
    for (int e = tid; e < 2 * 17 * 64; e += 512) { const int d = e / (17 * 64), tau = (e / 64) % 17, n = e & 63; const int gi = ((j * 2 + d) * 32 + g);
        const float dt = __expf(log_dt[gi]), ar = a_re[gi * 64 + n], ai = a_im[gi * 64 + n];
        const float mag = __expf(ar * dt * (float)tau); float sn, cs; __sincosf(ai * dt * (float)tau, &sn, &cs); pw[e] = (f32x2){mag * cs, mag * sn}; }
    for (int e = tid; e < 2 * 64 * 16; e += 512) { const int d = e / 1024, n = (e >> 4) & 63, c = e & 15; const int gi = ((j * 2 + d) * 32 + g);
        const float dt = __expf(log_dt[gi]), ar = a_re[gi * 64 + n], ai = a_im[gi * 64 + n];
        const float mag = __expf(ar * dt); float sn, cs; __sincosf(ai * dt, &sn, &cs); const float lr = mag * cs, li = mag * sn;
        const float den = ar * ar + ai * ai, nr = lr - 1.0f, qr = (nr * ar + li * ai) / den, qi = (li * ar - nr * ai) / den;
        const float br = b_re[((size_t)gi * 64 + n) * 16 + c], bi = b_im[((size_t)gi * 64 + n) * 16 + c];
        bb[e] = (f32x2){qr * br - qi * bi, qr * bi + qi * br}; }
    for (int e = tid; e < 2 * 16 * 64; e += 512) { const int d = e / 1024, c = (e >> 6) & 15, n = e & 63; const int gi = ((j * 2 + d) * 32 + g);
        cc[e] = (f32x2){c_re[((size_t)gi * 16 + c) * 64 + n], c_im[((size_t)gi * 16 + c) * 64 + n]}; }
    if (tid < 16) Dg[tid] = a->in[I_S5D][j * 512 + g * 16 + tid];
    __syncthreads();
    { const int d = tid >> 8, tau = (tid >> 4) & 15, c = tid & 15; float acc[16];
#pragma unroll
        for (int i = 0; i < 16; ++i) acc[i] = 0.f;
        for (int n = 0; n < 64; ++n) { const f32x2 C = cc[(d * 16 + c) * 64 + n], P = pw[(d * 17 + tau) * 64 + n]; const float mr = C.x * P.x - C.y * P.y, mi = C.x * P.y + C.y * P.x;
#pragma unroll
            for (int i = 0; i < 16; ++i) { const f32x2 B = bb[(d * 64 + n) * 16 + i]; acc[i] += mr * B.x - mi * B.y; } }
#pragma unroll
        for (int i = 0; i < 16; ++i) Kl[((d * 16 + tau) * 16 + c) * 16 + i] = acc[i]; }
    __syncthreads();
    bf16_t* W2g = W2 + (size_t)g * 256 * 512; bf16_t* Bg = Bmat + (size_t)g * 256 * 256;
    for (int e = part * 64 * 64 + tid; e < (part + 1) * 64 * 64; e += 512) { const int row = e >> 6, ch = e & 63, t = row >> 4, c = row & 15; float v[8];
        if (ch < 32) { const int s = ch >> 1, c0 = (ch & 1) * 8;
#pragma unroll
            for (int i = 0; i < 8; ++i) { const int cp = c0 + i; float x = 0.f;
                if (s <= t) x += Kl[((0 * 16 + (t - s)) * 16 + c) * 16 + cp];
                if (s >= t) x += Kl[((1 * 16 + (s - t)) * 16 + c) * 16 + cp];
                if (s == t && cp == c) x += Dg[c];
                v[i] = x; }
        } else { const int idx = (ch - 32) * 8, d = idx >> 7, ri = (idx >> 6) & 1, n0 = idx & 63; const int tau = d == 0 ? t + 1 : 16 - t;
#pragma unroll
            for (int i = 0; i < 8; ++i) { const f32x2 C = cc[(d * 16 + c) * 64 + n0 + i], P = pw[(d * 17 + tau) * 64 + n0 + i];
                v[i] = ri == 0 ? (C.x * P.x - C.y * P.y) : -(C.x * P.y + C.y * P.x); }
        }
        *(GAS u32x4*)(W2g + (size_t)row * 512 + ch * 8) = pack8(v); }
    for (int e = part * 64 * 32 + tid; e < (part + 1) * 64 * 32; e += 512) { const int row = e >> 5, ch = e & 31, d = row >> 7, ri = (row >> 6) & 1, n = row & 63, s = ch >> 1, c0 = (ch & 1) * 8; float v[8];
        const f32x2 P = pw[(d * 17 + (d == 0 ? 15 - s : s)) * 64 + n];
#pragma unroll
        for (int i = 0; i < 8; ++i) { const f32x2 B = bb[(d * 64 + n) * 16 + c0 + i]; v[i] = ri == 0 ? (P.x * B.x - P.y * B.y) : (P.x * B.y + P.y * B.x); }
        *(GAS u32x4*)(Bg + (size_t)row * 256 + ch * 8) = pack8(v); }
    __syncthreads();
}

template <bool PASSB>
__device__ __forceinline__ void s5_carry_seg(KArgs a, int j, int unit, const bf16_t* Hend, float* SEGE, bf16_t* UH, int lane) {
    const int segidx = unit >> 6, gd = unit & 63, g = gd >> 1, d = gd & 1;
    const int seq = segidx < 64 ? segidx >> 4 : 4, seg = segidx < 64 ? segidx & 15 : segidx - 64, segbase = segidx - seg;
    const int inst0 = seq < 4 ? seq * 512 : 2048, cnt = seq < 4 ? 512 : 1024;
    const int gi = (j * 2 + d) * 32 + g;
    const float dt = expf(a->in[I_S5LOGDT][gi]), ar = a->in[I_S5ARE][gi * 64 + lane], ai = a->in[I_S5AIM][gi * 64 + lane];
    const float mag = expf(ar * dt * 16.f); float sn, cs; sincosf(ai * dt * 16.f, &sn, &cs); const float lr = mag * cs, li = mag * sn;
    float hr = 0.f, hi = 0.f;
    if (PASSB) { float sr = lr, si = li;
#pragma unroll
        for (int q = 0; q < 5; ++q) { const float nr = sr * sr - si * si, ni = 2.f * sr * si; sr = nr; si = ni; }
        for (int s0 = 0; s0 < seg; s0 += 8) { float er[8], ei[8];
#pragma unroll
            for (int k = 0; k < 8; ++k) { const bool v = s0 + k < seg; const float* p = SEGE + ((size_t)(segbase + (v ? s0 + k : 0)) * 64 + gd) * 128 + lane; er[k] = v ? p[0] : 0.f; ei[k] = v ? p[64] : 0.f; }
#pragma unroll
            for (int k = 0; k < 8; ++k) if (s0 + k < seg) { const float nr = sr * hr - si * hi + er[k], ni = sr * hi + si * hr + ei[k]; hr = nr; hi = ni; } } }
    const GAS bf16_t* hp = (const GAS bf16_t*)Hend + (size_t)g * NINST * 256 + d * 128 + lane;
    GAS bf16_t* up = (GAS bf16_t*)UH + (size_t)g * NINST * 512 + 256 + d * 128 + lane;
    for (int i0 = 0; i0 < 32; i0 += 8) {
        float er[8], ei[8];
#pragma unroll
        for (int k = 0; k < 8; ++k) { const int q = 32 * seg + i0 + k; const int inst = inst0 + (d == 0 ? q : cnt - 1 - q); er[k] = bf2f(hp[(size_t)inst * 256]); ei[k] = bf2f(hp[(size_t)inst * 256 + 64]); }
#pragma unroll
        for (int k = 0; k < 8; ++k) { const int q = 32 * seg + i0 + k; const int inst = inst0 + (d == 0 ? q : cnt - 1 - q);
            if (PASSB) { up[(size_t)inst * 512] = (bf16_t)f2bf(hr); up[(size_t)inst * 512 + 64] = (bf16_t)f2bf(hi); }
            const float nr = lr * hr - li * hi + er[k], ni = lr * hi + li * hr + ei[k]; hr = nr; hi = ni; }
    }
    if (!PASSB) { float* p = SEGE + ((size_t)segidx * 64 + gd) * 128 + lane; p[0] = hr; p[64] = hi; }
}

constexpr int SH_SEG = 128, SH_NSEG = T / SH_SEG;
__device__ __forceinline__ bool seq_first_row(int t) { return t < TP ? (t & 8191) == 0 : t == TP; }
__device__ __forceinline__ bool seq_end_row(int t) { return t < TP ? (t & 8191) == 0 : (t == TP || t == T); }
__device__ __forceinline__ void shift_save_halo(const bf16_t* PRW, bf16_t* HALO, int task, int lane) {
    const int seg = task >> 1, which = task & 1, t0 = seg * SH_SEG;
    const int src = which == 0 ? t0 - 1 : t0 + SH_SEG; const bool valid = which == 0 ? !seq_first_row(t0) : !seq_end_row(t0 + SH_SEG);
    for (int ch = lane; ch < 208; ch += 64) { u32x4 v = {0u, 0u, 0u, 0u}; if (valid) v = *(const GAS u32x4*)(PRW + (size_t)src * PRW_LD + 8 * ch); *(GAS u32x4*)(HALO + ((size_t)task * 1664) + 8 * ch) = v; }
}
__device__ __forceinline__ float tanh_fast_(float x) { return 1.0f - 2.0f * __builtin_amdgcn_rcpf(__expf(2.0f * x) + 1.0f); }
__device__ __forceinline__ void shift_rows(KArgs a, int j, bf16_t* PRW, const bf16_t* HALO, int task, int lane) {
    const int seg = task >> 2, cg = task & 3, ch = cg * 64 + lane, t0 = seg * SH_SEG;
    if (ch >= 208) return;
    const bool is_lw = ch >= 192 && ch < 200;
    float mu[8]; { const f32x4 m0 = *(const GAS f32x4*)(a->in[I_RWMU] + j * 1664 + 8 * ch), m1 = *(const GAS f32x4*)(a->in[I_RWMU] + j * 1664 + 8 * ch + 4);
#pragma unroll
        for (int i = 0; i < 4; ++i) { mu[i] = m0[i]; mu[4 + i] = m1[i]; } }
    GAS bf16_t* base = (GAS bf16_t*)PRW + (size_t)t0 * PRW_LD + 8 * ch;
    float prev[8], cur[8];
    unpack8(*(const GAS u32x4*)(HALO + ((size_t)(2 * seg) * 1664) + 8 * ch), prev); unpack8(*(const GAS u32x4*)base, cur);
    float kkv[8];
#pragma unroll
    for (int i = 0; i < 8; ++i) kkv[i] = 0.f;
    if (cg == 1) { const f32x4 k0 = *(const GAS f32x4*)(a->in[I_RWKK] + j * 512 + 8 * lane), k1 = *(const GAS f32x4*)(a->in[I_RWKK] + j * 512 + 8 * lane + 4);
#pragma unroll
        for (int i = 0; i < 4; ++i) { kkv[i] = k0[i]; kkv[4 + i] = k1[i]; } }
    for (int r0 = 0; r0 < SH_SEG; r0 += 4) { u32x4 nx[4];
#pragma unroll
        for (int u = 0; u < 4; ++u) { const int r = r0 + u + 1; nx[u] = r < SH_SEG ? *(const GAS u32x4*)(base + (size_t)r * PRW_LD) : *(const GAS u32x4*)(HALO + ((size_t)(2 * seg + 1) * 1664) + 8 * ch); }
#pragma unroll
        for (int u = 0; u < 4; ++u) { float nxt[8], o[8]; unpack8(nx[u], nxt); float ss = 0.f;
#pragma unroll
            for (int i = 0; i < 8; ++i) { const float v = cur[i] + mu[i] * (0.5f * (prev[i] + nxt[i]) - cur[i]); o[i] = is_lw ? tanh_fast_(v) : v; prev[i] = cur[i]; cur[i] = nxt[i]; const float t = v * kkv[i]; ss += t * t; }
            *(GAS u32x4*)(base + (size_t)(r0 + u) * PRW_LD) = pack8(o);
            if (cg == 1) { ss = reduce8(ss); if ((lane & 7) == 0) *(GAS float*)((GAS bf16_t*)PRW + (size_t)(t0 + r0 + u) * PRW_LD + 2176 + 2 * (lane >> 3)) = 1.0f / fmaxf(sqrtf(ss), 1e-12f); } } }
}

__device__ __forceinline__ void lds_barrier() { asm volatile("s_waitcnt lgkmcnt(0)" ::: "memory"); __builtin_amdgcn_s_barrier(); asm volatile("" ::: "memory"); }
namespace rw {
constexpr int SC = 512, NSC = T / SC, NUNIT = NSC * 16;
constexpr int WK_BYTES = 65536, IMG_BYTES = 16384;
constexpr int RS = 144;
constexpr int O_W = 0, O_QG = 2304, O_BGT = 4608, O_KGT = 6656, O_VT = 8704, O_AQB = 10752, O_AQK = 11264, O_UT = 11776, O_GC = 15872;
constexpr int TMP_OFF = 32768, TMP_BYTES = 14336;
constexpr int T_LA = 0, T_TW = 2304, T_AG = 4608, T_AGT = 6912, T_BGI = 8960, T_KGI = 11264, T_AAB = 0, T_AAK = 1024, T_TINV = 1536;
#define MFMA16(a, b, c) __builtin_amdgcn_mfma_f32_16x16x32_bf16((a), (b), (c), 0, 0, 0)
__device__ __forceinline__ bf16x8 mk8(u32x2 lo, u32x2 hi) { const u32x4 v = {lo.x, lo.y, hi.x, hi.y}; return __builtin_bit_cast(bf16x8, v); }
__device__ __forceinline__ bf16x8 zero8() { const u32x4 v = {0u, 0u, 0u, 0u}; return __builtin_bit_cast(bf16x8, v); }
__device__ __forceinline__ void wave_lds_fence() { asm volatile("s_waitcnt lgkmcnt(0)" ::: "memory"); __builtin_amdgcn_wave_barrier(); asm volatile("" ::: "memory"); }

template <bool P3>
__device__ __forceinline__ void s1_issue(const bf16_t* PRW, int h, int d, int e, long sc_row0, int p0, int lane, u32x4 (&rl)[2][2], u32x2 (&rk4)[4], u32x2 (&rr)[2], u32x2 (&rv)[2]) {
    const int lr = lane & 15, kq = lane >> 4;
    const int tsc = d ? (SC - 1) - (p0 + lr) : (p0 + lr); const GAS bf16_t* rp = (const GAS bf16_t*)PRW + (sc_row0 + tsc) * PRW_LD;
#pragma unroll
    for (int ks = 0; ks < 2; ++ks) { rl[0][ks] = *(const GAS u32x4*)(rp + 1536 + 32 * ks + 8 * kq); rl[1][ks] = *(const GAS u32x4*)(rp + 1600 + 32 * ks + 8 * kq); }
#pragma unroll
    for (int cl = 0; cl < 2; ++cl) rk4[cl] = *(const GAS u32x2*)(rp + 512 + 64 * h + 16 * (2 * e + cl) + 4 * kq);
    rk4[2].x = *(const GAS unsigned*)(rp + 2176 + 2 * h); rk4[2].y = 0u; rk4[3] = (u32x2){0u, 0u};
#pragma unroll
    for (int cl = 0; cl < 2; ++cl) { rr[cl] = (u32x2){0u, 0u}; rv[cl] = *(const GAS u32x2*)(rp + 1024 + 64 * h + 16 * (2 * e + cl) + 4 * kq); }
}
constexpr int CST_OFF = 61440;
constexpr int BSP_OFF = 64256;

template <bool P3, int VAR = 0>
__device__ __forceinline__ void stage1(int h, int d, int s, int e, long sc_row0, int p0, bool nxt, LAS unsigned char* wl, const bf16_t* PRW, const bf16_t* aupT, const bf16x8 (&lwAp)[2][2], const bf16x8 (&lwW)[2][2], bf16_t* BON, float* BS,
                                       int lane, u32x4 (&rl)[2][2], u32x2 (&rk4)[4], u32x2 (&rr)[2], u32x2 (&rv)[2]) {
    LAS unsigned char* img = wl + s * IMG_BYTES; LAS unsigned char* tmp = wl + TMP_OFF + s * TMP_BYTES; const LAS float* cst = (const LAS float*)(wl + CST_OFF);
    LAS float* bsp = (LAS float*)(wl + BSP_OFF) + s * 32;
    const int lr = lane & 15, kq = lane >> 4;
    const int tsc = d ? (SC - 1) - (p0 + lr) : (p0 + lr); const long row = sc_row0 + tsc;
    float kx[8], rx[8], vx[8]; float inv;
    bf16x8 lwA[2][2];
#pragma unroll
    for (int cl = 0; cl < 2; ++cl)
#pragma unroll
        for (int ks = 0; ks < 2; ++ks) lwA[cl][ks] = lwAp[cl][ks];
    if (P3) {
#pragma unroll
        for (int cl = 0; cl < 2; ++cl) rr[cl] = *(const GAS u32x2*)((const GAS bf16_t*)PRW + row * PRW_LD + 64 * h + 16 * (2 * e + cl) + 4 * kq); }
    { inv = __builtin_bit_cast(float, rk4[2].x);
#pragma unroll
        for (int cl = 0; cl < 2; ++cl) { const int c0 = 16 * (2 * e + cl) + 4 * kq; const u32x2 wk = rk4[cl], wr = rr[cl], wv = rv[cl];
            kx[4 * cl] = bflo(wk.x); kx[4 * cl + 1] = bfhi(wk.x); kx[4 * cl + 2] = bflo(wk.y); kx[4 * cl + 3] = bfhi(wk.y);
            rx[4 * cl] = bflo(wr.x); rx[4 * cl + 1] = bfhi(wr.x); rx[4 * cl + 2] = bflo(wr.y); rx[4 * cl + 3] = bfhi(wr.y);
            vx[4 * cl] = bflo(wv.x); vx[4 * cl + 1] = bfhi(wv.x); vx[4 * cl + 2] = bflo(wv.y); vx[4 * cl + 3] = bfhi(wv.y);
            *(LAS bf16_t*)(img + O_VT + ((c0 + 0) * 16 + lr) * 2) = (bf16_t)(wv.x & 0xffffu); *(LAS bf16_t*)(img + O_VT + ((c0 + 1) * 16 + lr) * 2) = (bf16_t)(wv.x >> 16);
            *(LAS bf16_t*)(img + O_VT + ((c0 + 2) * 16 + lr) * 2) = (bf16_t)(wv.y & 0xffffu); *(LAS bf16_t*)(img + O_VT + ((c0 + 3) * 16 + lr) * 2) = (bf16_t)(wv.y >> 16); } }
    f32x4 accA[2], accW[2];
#pragma unroll
    for (int cl = 0; cl < 2; ++cl) { accA[cl] = (f32x4){0.f, 0.f, 0.f, 0.f}; accW[cl] = (f32x4){0.f, 0.f, 0.f, 0.f}; }
    if (!(VAR & 8))
#pragma unroll
    for (int ks = 0; ks < 2; ++ks) { const bf16x8 btw = __builtin_bit_cast(bf16x8, rl[0][ks]), bla = __builtin_bit_cast(bf16x8, rl[1][ks]);
#pragma unroll
        for (int cl = 0; cl < 2; ++cl) { accA[cl] = MFMA16(lwA[cl][ks], bla, accA[cl]); accW[cl] = MFMA16(lwW[cl][ks], btw, accW[cl]); } }
    float av[8], G[8];
#pragma unroll
    for (int cl = 0; cl < 2; ++cl) { const int c0 = 16 * (2 * e + cl) + 4 * kq;
        const f32x4 a0 = *(const LAS f32x4*)(cst + 5 * 64 + c0), w0 = *(const LAS f32x4*)(cst + 6 * 64 + c0);
#pragma unroll
        for (int r = 0; r < 4; ++r) { const int ix = 4 * cl + r; av[ix] = sigmoidf_(a0[r] + accA[cl][r]);
            const float lw = -0.6065306597126334f * sigmoidf_(w0[r] + accW[cl][r]);
            float x = lw; x += dpp_f<0x111>(x); x += dpp_f<0x112>(x); x += dpp_f<0x114>(x); x += dpp_f<0x118>(x); G[ix] = x; } }
    if (lr == 15) {
#pragma unroll
        for (int cl = 0; cl < 2; ++cl) *(LAS f32x4*)(img + O_GC + (16 * (2 * e + cl) + 4 * kq) * 4) = (f32x4){__expf(G[4 * cl]), __expf(G[4 * cl + 1]), __expf(G[4 * cl + 2]), __expf(G[4 * cl + 3])}; }
    float bs = 0.f;
#pragma unroll
    for (int cl = 0; cl < 2; ++cl) { float ag[4], bgi[4], kgi[4], qg[4]; const int c0 = 16 * (2 * e + cl) + 4 * kq;
        const f32x4 kk = *(const LAS f32x4*)(cst + 7 * 64 + c0), ka = *(const LAS f32x4*)(cst + 8 * 64 + c0), rk = *(const LAS f32x4*)(cst + 9 * 64 + c0);
#pragma unroll
        for (int r = 0; r < 4; ++r) { const int ix = 4 * cl + r; const float kap = kx[ix] * kk[r] * inv, b = kap * av[ix], k2 = kx[ix] * (1.0f + (av[ix] - 1.0f) * ka[r]);
            const float eg = __expf(G[ix]); const float egx = __builtin_bit_cast(float, __builtin_amdgcn_update_dpp(0x3f800000, __builtin_bit_cast(int, eg), 0x111, 0xf, 0xf, false));
            const float einv = __builtin_amdgcn_rcpf(eg);
            ag[r] = -kap * egx; bgi[r] = b * einv; kgi[r] = k2 * einv; qg[r] = rx[ix] * eg;
            if (P3) bs += rx[ix] * k2 * rk[r]; }
        u32x2 w;
        w.x = pk2(ag[0], ag[1]); w.y = pk2(ag[2], ag[3]); *(LAS u32x2*)(tmp + T_AG + lr * RS + c0 * 2) = w;
        w.x = pk2(bgi[0], bgi[1]); w.y = pk2(bgi[2], bgi[3]); *(LAS u32x2*)(tmp + T_BGI + lr * RS + c0 * 2) = w;
        w.x = pk2(kgi[0], kgi[1]); w.y = pk2(kgi[2], kgi[3]); *(LAS u32x2*)(tmp + T_KGI + lr * RS + c0 * 2) = w;
        if (P3) { w.x = pk2(qg[0], qg[1]); w.y = pk2(qg[2], qg[3]); *(LAS u32x2*)(img + O_QG + lr * RS + c0 * 2) = w; }
#pragma unroll
        for (int r = 0; r < 4; ++r) { *(LAS bf16_t*)(tmp + T_AGT + ((c0 + r) * 16 + lr) * 2) = (bf16_t)f2bf(ag[r]);
            *(LAS bf16_t*)(img + O_BGT + ((c0 + r) * 16 + lr) * 2) = (bf16_t)f2bf(bgi[r]); *(LAS bf16_t*)(img + O_KGT + ((c0 + r) * 16 + lr) * 2) = (bf16_t)f2bf(kgi[r]); }
        asm volatile("" ::: "memory"); }
    if (P3) { bs += __shfl_xor(bs, 16); bs += __shfl_xor(bs, 32); if (kq == 0) bsp[e * 16 + lr] = bs; }
    __syncthreads();
    if (P3 && d == 0 && BS) { if (e == 0 && kq == 0) BS[row * 8 + h] = bsp[lr] + bsp[16 + lr]; }
    else if (P3 && d == 0) { const float bt = bsp[lr] + bsp[16 + lr];
#pragma unroll
        for (int cl = 0; cl < 2; ++cl) { const int c0 = 16 * (2 * e + cl) + 4 * kq; u32x2 w; w.x = pk2(bt * vx[4 * cl], bt * vx[4 * cl + 1]); w.y = pk2(bt * vx[4 * cl + 2], bt * vx[4 * cl + 3]); *(GAS u32x2*)(BON + row * 512 + 64 * h + c0) = w; } }
    if (e == 0) {
        f32x4 dab = {0.f, 0.f, 0.f, 0.f}, dak = dab;
#pragma unroll
        for (int ks = 0; ks < 2; ++ks) { const int o = lr * RS + (32 * ks + 8 * kq) * 2;
            const bf16x8 fa = *(const LAS bf16x8*)(tmp + T_AG + o), fb = *(const LAS bf16x8*)(tmp + T_BGI + o), fk = *(const LAS bf16x8*)(tmp + T_KGI + o);
            dab = MFMA16(fa, fb, dab);
            dak = MFMA16(fk, fa, dak); }
        f32x4 lt; u32x2 w; float m[4];
#pragma unroll
        for (int r = 0; r < 4; ++r) lt[r] = (lr < 4 * kq + r) ? dab[r] : 0.f;
        *(LAS f32x4*)(tmp + T_AAB + (lr * 16 + 4 * kq) * 4) = lt;
#pragma unroll
        for (int r = 0; r < 4; ++r) m[r] = (4 * kq + r < lr) ? dak[r] : 0.f;
        w.x = pk2(m[0], m[1]); w.y = pk2(m[2], m[3]); *(LAS u32x2*)(tmp + T_AAK + (lr * 16 + 4 * kq) * 2) = w;
        wave_lds_fence();
        float x[16];
#pragma unroll
        for (int c2 = 7; c2 >= 0; --c2) { f32x4 l4[2][4];
#pragma unroll
            for (int cc = 0; cc < 2; ++cc)
#pragma unroll
                for (int q4 = 0; q4 < 4; ++q4) l4[cc][q4] = *(const LAS f32x4*)(tmp + T_AAB + ((2 * c2 + cc) * 16 + 4 * q4) * 4);
#pragma unroll
            for (int cc = 1; cc >= 0; --cc) { const int cidx = 2 * c2 + cc; float sacc = (lr == cidx) ? 1.f : 0.f;
#pragma unroll
                for (int i = 1; i < 16; ++i) if (i > cidx) sacc += x[i] * l4[cc][i >> 2][i & 3];
                x[cidx] = sacc; }
            asm volatile("" ::: "memory"); }
        if (kq == 0) { float lo8[8], hi8[8];
#pragma unroll
            for (int i = 0; i < 8; ++i) { lo8[i] = x[i]; hi8[i] = x[8 + i]; }
            *(LAS u32x4*)(tmp + T_TINV + lr * 32) = pack8(lo8); *(LAS u32x4*)(tmp + T_TINV + lr * 32 + 16) = pack8(hi8); }
    } else if (P3) {
        f32x4 dqb = {0.f, 0.f, 0.f, 0.f}, dqk = dqb;
#pragma unroll
        for (int ks = 0; ks < 2; ++ks) { const int o = lr * RS + (32 * ks + 8 * kq) * 2;
            const bf16x8 fb = *(const LAS bf16x8*)(tmp + T_BGI + o), fk = *(const LAS bf16x8*)(tmp + T_KGI + o), fq = *(const LAS bf16x8*)(img + O_QG + o);
            dqb = MFMA16(fb, fq, dqb);
            dqk = MFMA16(fk, fq, dqk); }
        u32x2 w; float m[4];
#pragma unroll
        for (int r = 0; r < 4; ++r) m[r] = (4 * kq + r <= lr) ? dqb[r] : 0.f;
        w.x = pk2(m[0], m[1]); w.y = pk2(m[2], m[3]); *(LAS u32x2*)(img + O_AQB + (lr * 16 + 4 * kq) * 2) = w;
#pragma unroll
        for (int r = 0; r < 4; ++r) m[r] = (4 * kq + r <= lr) ? dqk[r] : 0.f;
        w.x = pk2(m[0], m[1]); w.y = pk2(m[2], m[3]); *(LAS u32x2*)(img + O_AQK + (lr * 16 + 4 * kq) * 2) = w;
    }
    asm volatile("" ::: "memory");
    if (nxt && !(VAR & 4)) s1_issue<P3>(PRW, h, d, e, sc_row0, p0 + 32, lane, rl, rk4, rr, rv);
    __syncthreads();
    { const bf16x8 tB = kq < 2 ? *(const LAS bf16x8*)(tmp + T_TINV + (lr * 16 + 8 * kq) * 2) : zero8();
        const bf16x8 tA = mk8(*(const LAS u32x2*)(tmp + T_TINV + (lr * 16 + 4 * kq) * 2), (u32x2){0u, 0u});
        const bf16x8 akA = kq < 2 ? *(const LAS bf16x8*)(tmp + T_AAK + (lr * 16 + 8 * kq) * 2) : zero8();
#pragma unroll
        for (int cl = 0; cl < 2; ++cl) { const int ct = 2 * e + cl; const bf16x8 gA = kq < 2 ? *(const LAS bf16x8*)(tmp + T_AGT + ((16 * ct + lr) * 16 + 8 * kq) * 2) : zero8();
            const f32x4 wv = MFMA16(gA, tB, ((f32x4){0.f, 0.f, 0.f, 0.f}));
            u32x2 w; w.x = pk2(wv[0], wv[1]); w.y = pk2(wv[2], wv[3]); *(LAS u32x2*)(img + O_W + lr * RS + (16 * ct + 4 * kq) * 2) = w;
            const bf16x8 vB = kq < 2 ? *(const LAS bf16x8*)(img + O_VT + ((16 * ct + lr) * 16 + 8 * kq) * 2) : zero8();
            const f32x4 avd = MFMA16(akA, vB, ((f32x4){0.f, 0.f, 0.f, 0.f}));
            const bf16x8 avB = mk8((u32x2){pk2(avd[0], avd[1]), pk2(avd[2], avd[3])}, (u32x2){0u, 0u});
            const f32x4 ut = MFMA16(tA, avB, ((f32x4){0.f, 0.f, 0.f, 0.f}));
#pragma unroll
            for (int r = 0; r < 4; ++r) *(LAS float*)(img + O_UT + ((4 * kq + r) * 64 + 16 * ct + lr) * 4) = ut[r]; } }
}

template <bool P3, bool EM = false>
__device__ __forceinline__ void stage2(LAS unsigned char* img, f32x4 (&hk)[4], f32x4 (&pk)[4], int wv, int lane, bf16_t* Yrow0, int d, int p0, bf16_t* Erow0 = nullptr) {
    const int lr = lane & 15, kq = lane >> 4;
    const bf16x8 hB0 = mk8((u32x2){pk2(hk[0][0], hk[0][1]), pk2(hk[0][2], hk[0][3])}, (u32x2){pk2(hk[1][0], hk[1][1]), pk2(hk[1][2], hk[1][3])});
    const bf16x8 hB1 = mk8((u32x2){pk2(hk[2][0], hk[2][1]), pk2(hk[2][2], hk[2][3])}, (u32x2){pk2(hk[3][0], hk[3][1]), pk2(hk[3][2], hk[3][3])});
    const bf16x8 wA0 = mk8(*(const LAS u32x2*)(img + O_W + lr * RS + (4 * kq) * 2), *(const LAS u32x2*)(img + O_W + lr * RS + (16 + 4 * kq) * 2));
    const bf16x8 wA1 = mk8(*(const LAS u32x2*)(img + O_W + lr * RS + (32 + 4 * kq) * 2), *(const LAS u32x2*)(img + O_W + lr * RS + (48 + 4 * kq) * 2));
    f32x4 u;
#pragma unroll
    for (int r = 0; r < 4; ++r) u[r] = *(const LAS float*)(img + O_UT + ((4 * kq + r) * 64 + 16 * wv + lr) * 4);
    u = MFMA16(wA0, hB0, u); u = MFMA16(wA1, hB1, u);
    const bf16x8 uB = mk8((u32x2){pk2(u[0], u[1]), pk2(u[2], u[3])}, (u32x2){0u, 0u});
    const bf16x8 vB = kq < 2 ? *(const LAS bf16x8*)(img + O_VT + ((16 * wv + lr) * 16 + 8 * kq) * 2) : zero8();
    if (P3) {
        const bf16x8 qA0 = mk8(*(const LAS u32x2*)(img + O_QG + lr * RS + (4 * kq) * 2), *(const LAS u32x2*)(img + O_QG + lr * RS + (16 + 4 * kq) * 2));
        const bf16x8 qA1 = mk8(*(const LAS u32x2*)(img + O_QG + lr * RS + (32 + 4 * kq) * 2), *(const LAS u32x2*)(img + O_QG + lr * RS + (48 + 4 * kq) * 2));
        const bf16x8 bA = mk8(*(const LAS u32x2*)(img + O_AQB + (lr * 16 + 4 * kq) * 2), (u32x2){0u, 0u});
        const bf16x8 kA = kq < 2 ? *(const LAS bf16x8*)(img + O_AQK + (lr * 16 + 8 * kq) * 2) : zero8();
        const int tsc_o = d ? (SC - 1) - (p0 + lr) : (p0 + lr);
        f32x4 o = {0.f, 0.f, 0.f, 0.f};
        o = MFMA16(hB0, qA0, o); o = MFMA16(hB1, qA1, o); o = MFMA16(uB, bA, o); o = MFMA16(vB, kA, o);
        { u32x2 w; w.x = pk2(o[0], o[1]); w.y = pk2(o[2], o[3]); *(GAS u32x2*)(Yrow0 + (size_t)tsc_o * 512 + 16 * wv + 4 * kq) = w; }
        if (EM) {
            const bf16x8 pB0 = mk8((u32x2){pk2(pk[0][0], pk[0][1]), pk2(pk[0][2], pk[0][3])}, (u32x2){pk2(pk[1][0], pk[1][1]), pk2(pk[1][2], pk[1][3])});
            const bf16x8 pB1 = mk8((u32x2){pk2(pk[2][0], pk[2][1]), pk2(pk[2][2], pk[2][3])}, (u32x2){pk2(pk[3][0], pk[3][1]), pk2(pk[3][2], pk[3][3])});
            f32x4 up = {0.f, 0.f, 0.f, 0.f}; up = MFMA16(wA0, pB0, up); up = MFMA16(wA1, pB1, up);
            const bf16x8 upB = mk8((u32x2){pk2(up[0], up[1]), pk2(up[2], up[3])}, (u32x2){0u, 0u});
            f32x4 ev = {0.f, 0.f, 0.f, 0.f};
            ev = MFMA16(pB0, qA0, ev); ev = MFMA16(pB1, qA1, ev); ev = MFMA16(upB, bA, ev);
            { u32x2 w; w.x = pk2(ev[0], ev[1]); w.y = pk2(ev[2], ev[3]); *(GAS u32x2*)(Erow0 + (size_t)tsc_o * 512 + 16 * wv + 4 * kq) = w; }
#pragma unroll
            for (int kt = 0; kt < 4; ++kt) { const f32x4 gc = *(const LAS f32x4*)(img + O_GC + (16 * kt + 4 * kq) * 4);
                const bf16x8 bgA = mk8(*(const LAS u32x2*)(img + O_BGT + ((16 * kt + lr) * 16 + 4 * kq) * 2), (u32x2){0u, 0u});
                pk[kt] = MFMA16(bgA, upB, pk[kt]) * gc; } }
    } else {
        const bf16x8 pB0 = mk8((u32x2){pk2(pk[0][0], pk[0][1]), pk2(pk[0][2], pk[0][3])}, (u32x2){pk2(pk[1][0], pk[1][1]), pk2(pk[1][2], pk[1][3])});
        const bf16x8 pB1 = mk8((u32x2){pk2(pk[2][0], pk[2][1]), pk2(pk[2][2], pk[2][3])}, (u32x2){pk2(pk[3][0], pk[3][1]), pk2(pk[3][2], pk[3][3])});
        f32x4 up = {0.f, 0.f, 0.f, 0.f}; up = MFMA16(wA0, pB0, up); up = MFMA16(wA1, pB1, up);
        const bf16x8 upB = mk8((u32x2){pk2(up[0], up[1]), pk2(up[2], up[3])}, (u32x2){0u, 0u});
#pragma unroll
        for (int kt = 0; kt < 4; ++kt) { const f32x4 gc = *(const LAS f32x4*)(img + O_GC + (16 * kt + 4 * kq) * 4);
            const bf16x8 bgA = mk8(*(const LAS u32x2*)(img + O_BGT + ((16 * kt + lr) * 16 + 4 * kq) * 2), (u32x2){0u, 0u});
            pk[kt] = MFMA16(bgA, upB, pk[kt]) * gc; }
    }
    asm volatile("" ::: "memory");
#pragma unroll
    for (int kt = 0; kt < 4; ++kt) { const f32x4 gc = *(const LAS f32x4*)(img + O_GC + (16 * kt + 4 * kq) * 4);
        const bf16x8 bgA = mk8(*(const LAS u32x2*)(img + O_BGT + ((16 * kt + lr) * 16 + 4 * kq) * 2), (u32x2){0u, 0u});
        const bf16x8 kgA = kq < 2 ? *(const LAS bf16x8*)(img + O_KGT + ((16 * kt + lr) * 16 + 8 * kq) * 2) : zero8();
        f32x4 hn = hk[kt]; hn = MFMA16(bgA, uB, hn); hn = MFMA16(kgA, vB, hn); hk[kt] = hn * gc; }
}

template <bool P3, int VAR = 0, bool EM = false>
__device__ __forceinline__ void unit_pair(KArgs a, int j, int item, LAS unsigned char* lds, const bf16_t* PRW, const bf16_t* lora, float* PS, float* HS, bf16_t* Y0, bf16_t* Y1, bf16_t* BON, bf16_t* MIX, int tid, bf16_t* E0 = nullptr, bf16_t* E1 = nullptr, float* BS = nullptr) {
    const int lane = tid & 63, wid = __builtin_amdgcn_readfirstlane(tid >> 6), wk = wid >> 2, wv = wid & 3, lr = lane & 15, kq = lane >> 4;
    const int sc = item >> 3, h = item & 7, d = wk;
    const long sc_row0 = (long)sc * SC;
    const int unit = (sc * 8 + h) * 2 + d;
    LAS unsigned char* wl = lds + wk * WK_BYTES;
    LAS float* cst = (LAS float*)(wl + CST_OFF);
    const bf16_t* aupT = lora; const bf16_t* wupT = lora + (size_t)(1 + d) * 512 * 64;
    { const int t = tid & 255;
        for (int e = t; e < 640; e += 256) { const int which = e >> 6, cc = e & 63; float v;
            if (which < 5) v = 0.f;
            else if (which == 5) v = a->in[I_RWA0][j * 512 + 64 * h + cc];
            else if (which == 6) v = a->in[I_RWW0][(j * 2 + d) * 512 + 64 * h + cc];
            else if (which == 7) v = a->in[I_RWKK][j * 512 + 64 * h + cc];
            else if (which == 8) v = a->in[I_RWKA][j * 512 + 64 * h + cc];
            else v = a->in[I_RWRK][j * 512 + 64 * h + cc];
            cst[e] = v; } }
    f32x4 hk[4], pk[4];
#pragma unroll
    for (int kt = 0; kt < 4; ++kt) {
#pragma unroll
        for (int r = 0; r < 4; ++r) { const int k = 16 * kt + 4 * kq + r;
            hk[kt][r] = (P3 && !EM) ? HS[(size_t)unit * 4096 + k * 64 + 16 * wv + lr] : 0.f; pk[kt][r] = (k == 16 * wv + lr) ? 1.f : 0.f; } }
    const int s1 = wv & 1, e1 = wv >> 1;
    bf16_t* Yrow0 = (d == 0 ? Y0 : Y1) + sc_row0 * 512 + 64 * h; bf16_t* Erow0 = EM ? (d == 0 ? E0 : E1) + sc_row0 * 512 + 64 * h : nullptr;
    u32x4 rl[2][2]; u32x2 rk4[4], rr[2], rv[2];
    bf16x8 lwW[2][2], lwAp[2][2];
#pragma unroll
    for (int cl = 0; cl < 2; ++cl)
#pragma unroll
        for (int ks = 0; ks < 2; ++ks) { const size_t wo = (size_t)(64 * h + 16 * (2 * e1 + cl) + lr) * 64 + 32 * ks + 8 * kq; lwW[cl][ks] = *(const GAS bf16x8*)(wupT + wo); lwAp[cl][ks] = *(const GAS bf16x8*)(aupT + wo); }
    s1_issue<P3>(PRW, h, d, e1, sc_row0, 16 * s1, lane, rl, rk4, rr, rv);
    __syncthreads();
#pragma unroll 1
    for (int m = 0; m < SC / 32; ++m) {
        int ln = lane; asm volatile("" : "+v"(ln));
        if (!(VAR & 1)) stage1<P3, VAR>(h, d, s1, e1, sc_row0, 32 * m + 16 * s1, m + 1 < SC / 32, wl, PRW, aupT, lwAp, lwW, BON, BS, ln, rl, rk4, rr, rv);
        __syncthreads();
        if (!(VAR & 2)) { asm volatile("" : "+v"(ln) :: "memory"); stage2<P3, EM>(wl, hk, pk, wv, ln, Yrow0, d, 32 * m, Erow0);
        stage2<P3, EM>(wl + IMG_BYTES, hk, pk, wv, ln, Yrow0, d, 32 * m + 16, Erow0); }
        asm volatile("" ::: "memory"); __syncthreads();
    }
    if (P3 && !EM) {
        asm volatile("s_waitcnt vmcnt(0)" ::: "memory"); __syncthreads();
        const int ch = 64 * h + 8 * (tid & 7); float g[8], b[8];
        { const f32x4 g0 = *(const GAS f32x4*)(a->in[I_RWLNG] + j * 512 + ch), g1 = *(const GAS f32x4*)(a->in[I_RWLNG] + j * 512 + ch + 4), b0 = *(const GAS f32x4*)(a->in[I_RWLNB] + j * 512 + ch), b1 = *(const GAS f32x4*)(a->in[I_RWLNB] + j * 512 + ch + 4);
#pragma unroll
          for (int i = 0; i < 4; ++i) { g[i] = g0[i]; g[4 + i] = g1[i]; b[i] = b0[i]; b[4 + i] = b1[i]; } }
        for (int pass0 = 0; pass0 < SC / 64; pass0 += 4) {
            u32x4 ya[4], yb[4], bo[4], zz[4];
#pragma unroll
            for (int u = 0; u < 4; ++u) { const size_t row = (size_t)sc_row0 + (pass0 + u) * 64 + (tid >> 3); const size_t o = row * 512 + ch;
                ya[u] = *(const GAS u32x4*)(Y0 + o); yb[u] = *(const GAS u32x4*)(Y1 + o); bo[u] = *(const GAS u32x4*)(BON + o); zz[u] = *(const GAS u32x4*)(PRW + row * PRW_LD + 1664 + ch); }
#pragma unroll
            for (int u = 0; u < 4; ++u) { const size_t row = (size_t)sc_row0 + (pass0 + u) * 64 + (tid >> 3);
                float y0[8], y1[8], bn[8], z[8], ov[8];
                unpack8(ya[u], y0); unpack8(yb[u], y1); unpack8(bo[u], bn); unpack8(zz[u], z);
                float sm = 0.f;
#pragma unroll
                for (int i = 0; i < 8; ++i) { y0[i] += y1[i]; sm += y0[i]; }
                const float mean = reduce8(sm) * (1.f / 64.f); float sv = 0.f;
#pragma unroll
                for (int i = 0; i < 8; ++i) { y0[i] -= mean; sv += y0[i] * y0[i]; }
                const float rstd = 1.0f / sqrtf(reduce8(sv) * (1.f / 64.f) + 64e-5f);
#pragma unroll
                for (int i = 0; i < 8; ++i) ov[i] = (y0[i] * rstd * g[i] + b[i] + bn[i]) * siluf_(z[i]);
                *(GAS u32x4*)(MIX + row * 1024 + 512 + ch) = pack8(ov); } }
    }
    if (!P3 || EM) { float* hsb = HS + (size_t)unit * 4096 + 16 * wv; float* psb = PS + (size_t)unit * 4096 + 16 * wv; int l2 = lane; asm volatile("" : "+v"(l2)); const unsigned hoff = (unsigned)(4 * (l2 >> 4) * 64 + (l2 & 15));
#pragma unroll
        for (int kt = 0; kt < 4; ++kt)
#pragma unroll
            for (int r = 0; r < 4; ++r) { hsb[hoff + (16 * kt + r) * 64] = hk[kt][r]; psb[hoff + (16 * kt + r) * 64] = pk[kt][r]; } }
}

__device__ __forceinline__ void chain_states(int chain, LAS unsigned char* lds, const float* PS, float* HS, int tid) {
    int seq, h, d;
    if (chain < 16) { seq = 4; h = chain >> 1; d = chain & 1; } else { const int c = chain - 16; seq = c >> 4; h = (c >> 1) & 7; d = c & 1; }
    const int sc0 = seq < 4 ? seq * 16 : 64, n = seq < 4 ? 16 : 32;
    LAS float* cur = (LAS float*)lds;
    const int k = tid >> 3, vg = (tid & 7) * 8;
    { float z = 0.f; asm volatile("" : "+v"(z));
#pragma unroll
      for (int i = 0; i < 8; ++i) cur[k * 64 + vg + i] = z; }
    f32x4 pr[16], hs0, hs1;
    { const int sc = d ? sc0 + n - 1 : sc0; const size_t uo = (size_t)((sc * 8 + h) * 2 + d) * 4096;
      hs0 = *(const GAS f32x4*)(HS + uo + k * 64 + vg); hs1 = *(const GAS f32x4*)(HS + uo + k * 64 + vg + 4);
#pragma unroll
      for (int q = 0; q < 16; ++q) pr[q] = *(const GAS f32x4*)(PS + uo + k * 64 + 4 * q); }
    __syncthreads();
    for (int i = 0; i < n; ++i) { const int sc = d ? sc0 + n - 1 - i : sc0 + i; const size_t uo = (size_t)((sc * 8 + h) * 2 + d) * 4096;
        float acc[8] = {hs0[0], hs0[1], hs0[2], hs0[3], hs1[0], hs1[1], hs1[2], hs1[3]};
        f32x4 pc[16];
#pragma unroll
        for (int q = 0; q < 16; ++q) pc[q] = pr[q];
        if (i + 1 < n) { const int sn = d ? sc0 + n - 2 - i : sc0 + i + 1; const size_t un = (size_t)((sn * 8 + h) * 2 + d) * 4096;
            hs0 = *(const GAS f32x4*)(HS + un + k * 64 + vg); hs1 = *(const GAS f32x4*)(HS + un + k * 64 + vg + 4);
#pragma unroll
            for (int q = 0; q < 16; ++q) pr[q] = *(const GAS f32x4*)(PS + un + k * 64 + 4 * q); }
#pragma unroll
        for (int q = 0; q < 16; ++q) {
#pragma unroll
            for (int e = 0; e < 4; ++e) { const f32x4 c0 = *(const LAS f32x4*)(cur + (4 * q + e) * 64 + vg), c1 = *(const LAS f32x4*)(cur + (4 * q + e) * 64 + vg + 4); const float p = pc[q][e];
                acc[0] += p * c0[0]; acc[1] += p * c0[1]; acc[2] += p * c0[2]; acc[3] += p * c0[3]; acc[4] += p * c1[0]; acc[5] += p * c1[1]; acc[6] += p * c1[2]; acc[7] += p * c1[3]; } }
        const f32x4 o0 = *(const LAS f32x4*)(cur + k * 64 + vg), o1 = *(const LAS f32x4*)(cur + k * 64 + vg + 4);
        *(GAS f32x4*)(HS + uo + k * 64 + vg) = o0; *(GAS f32x4*)(HS + uo + k * 64 + vg + 4) = o1;
        __syncthreads();
        *(LAS f32x4*)(cur + k * 64 + vg) = (f32x4){acc[0], acc[1], acc[2], acc[3]}; *(LAS f32x4*)(cur + k * 64 + vg + 4) = (f32x4){acc[4], acc[5], acc[6], acc[7]};
        __syncthreads(); }
}

__device__ __forceinline__ float reduce16(float x) { x += dpp_f<0xB1>(x); x += dpp_f<0x4E>(x); x += dpp_f<0x141>(x); x += dpp_f<0x140>(x); return x; }
__device__ __forceinline__ void fix_unit(KArgs a, int j, int item, LAS unsigned char* lds, const bf16_t* PRW, const float* HS, const bf16_t* Y0, const bf16_t* Y1, const bf16_t* E0, const bf16_t* E1, const float* BS, bf16_t* MIX, int tid) {
    const int lane = tid & 63, wid = __builtin_amdgcn_readfirstlane(tid >> 6), lr = lane & 15, kq = lane >> 4;
    const int sc = item >> 3, h = item & 7; const long row0 = (long)sc * SC;
    LAS float* gl = (LAS float*)lds; LAS unsigned char* fr = lds + 512;
    lds_barrier();
    if (tid < 64) { gl[tid] = a->in[I_RWLNG][j * 512 + 64 * h + tid]; gl[64 + tid] = a->in[I_RWLNB][j * 512 + 64 * h + tid]; }
#pragma unroll
    for (int q = 0; q < 2; ++q) { const int f = 2 * wid + q, d = f >> 3, vt = (f >> 1) & 3, ks = f & 1; float fv[8];
        const float* hp = HS + (size_t)((sc * 8 + h) * 2 + d) * 4096 + 16 * (lr >> 2) + (lr & 3) + 4 * vt;
#pragma unroll
        for (int e = 0; e < 8; ++e) fv[e] = hp[(32 * ks + 8 * kq + e) * 64];
        *(LAS u32x4*)(fr + 1024 * f + 16 * lane) = pack8(fv); }
    lds_barrier();
    size_t row[2]; bf16x8 eB[2][2][2]; u32x4 yf[2][2], yb[2][2], vw[2][2], zw[2][2]; float bon[2];
#define FX_LOAD(bf, tile_) do { row[bf] = (size_t)(row0 + 16 * (tile_) + lr); \
        _Pragma("unroll") for (int d = 0; d < 2; ++d) _Pragma("unroll") for (int ks = 0; ks < 2; ++ks) eB[bf][d][ks] = *(const GAS bf16x8*)((d == 0 ? E0 : E1) + row[bf] * 512 + 64 * h + 32 * ks + 8 * kq); \
        _Pragma("unroll") for (int hf = 0; hf < 2; ++hf) { const size_t o_ = row[bf] * 512 + 64 * h + 16 * kq + 8 * hf; yf[bf][hf] = *(const GAS u32x4*)(Y0 + o_); yb[bf][hf] = *(const GAS u32x4*)(Y1 + o_); \
            vw[bf][hf] = *(const GAS u32x4*)(PRW + row[bf] * PRW_LD + 1024 + 64 * h + 16 * kq + 8 * hf); zw[bf][hf] = *(const GAS u32x4*)(PRW + row[bf] * PRW_LD + 1664 + 64 * h + 16 * kq + 8 * hf); } \
        bon[bf] = BS[row[bf] * 8 + h]; } while (0)
    FX_LOAD(0, wid);
#pragma unroll
    for (int it = 0; it < SC / 16 / NWAVES; ++it) { const int cb = it & 1;
        if (it + 1 < SC / 16 / NWAVES) FX_LOAD(cb ^ 1, wid + NWAVES * (it + 1));
        asm volatile("" ::: "memory");
        f32x4 acc[4];
#pragma unroll
        for (int hf = 0; hf < 2; ++hf) { float y0[8], y1[8]; unpack8(yf[cb][hf], y0); unpack8(yb[cb][hf], y1);
#pragma unroll
            for (int i = 0; i < 8; ++i) acc[2 * hf + (i >> 2)][i & 3] = y0[i] + y1[i]; }
#pragma unroll
        for (int vt = 0; vt < 4; ++vt)
#pragma unroll
            for (int d = 0; d < 2; ++d)
#pragma unroll
                for (int ks = 0; ks < 2; ++ks) acc[vt] = MFMA16(*(const LAS bf16x8*)(fr + 1024 * (8 * d + 2 * vt + ks) + 16 * lane), eB[cb][d][ks], acc[vt]);
        float sm = 0.f;
#pragma unroll
        for (int vt = 0; vt < 4; ++vt) sm += (acc[vt][0] + acc[vt][1]) + (acc[vt][2] + acc[vt][3]);
        sm += __shfl_xor(sm, 16); sm += __shfl_xor(sm, 32); const float mean = sm * (1.f / 64.f);
        float sv = 0.f;
#pragma unroll
        for (int vt = 0; vt < 4; ++vt)
#pragma unroll
            for (int r = 0; r < 4; ++r) { const float t = acc[vt][r] - mean; acc[vt][r] = t; sv += t * t; }
        sv += __shfl_xor(sv, 16); sv += __shfl_xor(sv, 32); const float rstd = 1.0f / sqrtf(sv * (1.f / 64.f) + 64e-5f);
#pragma unroll
        for (int hf = 0; hf < 2; ++hf) { float vv[8], zz[8], ov[8]; unpack8(vw[cb][hf], vv); unpack8(zw[cb][hf], zz);
            const f32x4 g0 = *(const LAS f32x4*)(gl + 16 * kq + 8 * hf), g1 = *(const LAS f32x4*)(gl + 16 * kq + 8 * hf + 4), b0 = *(const LAS f32x4*)(gl + 64 + 16 * kq + 8 * hf), b1 = *(const LAS f32x4*)(gl + 64 + 16 * kq + 8 * hf + 4);
#pragma unroll
            for (int i = 0; i < 8; ++i) { const int vt = 2 * hf + (i >> 2), r = i & 3; const float gg = i < 4 ? g0[i & 3] : g1[i & 3], bb = i < 4 ? b0[i & 3] : b1[i & 3];
                ov[i] = (acc[vt][r] * rstd * gg + bb + bon[cb] * vv[i]) * siluf_(zz[i]); }
            *(GAS u32x4*)(MIX + row[cb] * 1024 + 512 + 64 * h + 16 * kq + 8 * hf) = pack8(ov); }
        asm volatile("" ::: "memory");
    }
#undef FX_LOAD
}
}

__device__ __forceinline__ int crow(int r, int hi) { return (r & 3) + 8 * (r >> 2) + 4 * hi; }
constexpr int AT_KSTR = 144;
constexpr int AT_VSTR = 128;
constexpr int AT_VOFF = 384 * AT_KSTR;
__device__ __forceinline__ float attn_mref2(KArgs a, int j) {
    int ln = lane_id(); float gqm = fabsf(a->in[I_ATQN][j * 64 + ln]), gkm = fabsf(a->in[I_ATKN][j * 64 + ln]);
#pragma unroll
    for (int o = 1; o < 64; o <<= 1) { gqm = fmaxf(gqm, __shfl_xor(gqm, o)); gkm = fmaxf(gkm, __shfl_xor(gkm, o)); }
    return __builtin_bit_cast(float, __builtin_amdgcn_readfirstlane(__builtin_bit_cast(int, 8.2f * gqm * gkm * 1.4426950408889634f))); }
template <int AVAR = 0>
__device__ __forceinline__ void attn_unit(KArgs a, int j, int unit, LAS unsigned char* lds, const bf16_t* PO, bf16_t* MIX, const int tid, const float mref2) {
    const int qbg = unit >> 2, kvh = unit & 3;
    const int t0 = qbg * 128; const int row0 = t0 < TP ? (t0 & ~8191) : TP, Ls = t0 < TP ? 8192 : 16384;
    const int qb = (t0 - row0) >> 7, nb = Ls >> 7;
    const int lane = tid & 63, wid = __builtin_amdgcn_readfirstlane(tid >> 6), q = lane & 31, hi = lane >> 5;
    const float LOG2E = 1.4426950408889634f;
    u32x4 qraw[4];
    { const int item = wid, g = item >> 2, qi = item & 3, hh = 4 * kvh + g; const size_t qrow = (size_t)(t0 + 32 * qi + q);
#pragma unroll
        for (int ks = 0; ks < 4; ++ks) qraw[ks] = *(const GAS u32x4*)(PO + qrow * OD_N + 64 * hh + 16 * ks + 8 * hi); }
    if (!(AVAR & 1)) { const float* gk = a->in[I_ATKN] + j * 64; const float* gqs = a->in[I_ATQN] + j * 64; int tid_s = tid; asm volatile("" : "+v"(tid_s));
#pragma unroll
        for (int i = 0; i < 6; ++i) { const int id = i * 512 + tid_s, srel = id >> 3, ch = id & 7; const int kb = i >> 1; const int blk = qb - 1 + kb;
            if (blk >= 0 && blk < nb) { const bf16_t* ub = PO + (size_t)(row0 + blk * 128 + (i & 1) * 64) * OD_N + 1024 + 64 * kvh;
                const unsigned toff = (unsigned)((tid_s >> 3) * OD_N + 8 * ch);
                float kf[8]; unpack8(*(const GAS u32x4*)(ub + toff), kf); const u32x4 vraw = *(const GAS u32x4*)(ub + 256 + toff);
                float ss = 0.f;
#pragma unroll
                for (int e = 0; e < 8; ++e) ss += kf[e] * kf[e];
                ss = reduce8(ss); const float rstd = 1.0f / sqrtf(ss * (1.f / 64.f) + 1e-6f);
#pragma unroll
                for (int e = 0; e < 8; ++e) kf[e] = kf[e] * rstd * (gk[8 * ch + e] * gqs[8 * ch + e]);
                *(LAS u32x4*)(lds + srel * AT_KSTR + ch * 16) = pack8(kf);
                *(LAS u32x4*)(lds + AT_VOFF + srel * AT_VSTR + ((ch ^ (4 * ((srel >> 1) & 1))) * 16)) = vraw; }
            else { *(LAS u32x4*)(lds + srel * AT_KSTR + ch * 16) = u32x4{0u, 0u, 0u, 0u}; *(LAS u32x4*)(lds + AT_VOFF + srel * AT_VSTR + ch * 16) = u32x4{0u, 0u, 0u, 0u}; } } }
    lds_barrier();
    if (!(AVAR & 2))
#pragma unroll
    for (int it = 0; it < 2; ++it) { const int item = wid + 8 * it, g = item >> 2, qi = item & 3, hh = 4 * kvh + g;
        const size_t qrow = (size_t)(t0 + 32 * qi + q);
        bf16x8 qf[4];
        { float qv[4][8]; float ss = 0.f;
#pragma unroll
            for (int ks = 0; ks < 4; ++ks) { unpack8(qraw[ks], qv[ks]);
#pragma unroll
                for (int e = 0; e < 8; ++e) ss += qv[ks][e] * qv[ks][e]; }
            ss += __shfl_xor(ss, 32); const float sc = (1.0f / sqrtf(ss * (1.f / 64.f) + 1e-6f)) * 0.125f * LOG2E;
#pragma unroll
            for (int ks = 0; ks < 4; ++ks) { float w[8];
#pragma unroll
                for (int e = 0; e < 8; ++e) w[e] = qv[ks][e] * sc;
                qf[ks] = __builtin_bit_cast(bf16x8, pack8(w)); } }
        u32x2 zpre[8];
        const float slope2 = exp2f(-0.5f * (float)(hh + 1)) * LOG2E;
        const float sinkv = a->in[I_ATSINK][j * 16 + hh]; float lpart = 0.0f;
        f32x16 o0, o1;
#pragma unroll
        for (int r = 0; r < 16; ++r) { o0[r] = 0.f; o1[r] = 0.f; }
        const float tq0 = (float)(q - 4 * hi);
        const float v0f = qb >= 1 ? 1.0f : 0.0f, v2f = qb + 1 < nb ? 1.0f : 0.0f;
        LAS unsigned char* kp = lds + (32 * qi + q) * AT_KSTR + hi * 16;
        LAS unsigned char* vp0; LAS unsigned char* vp1;
        { const int qq = (lane & 15) >> 2, pp = lane & 3, dsub = (lane >> 4) & 1, sw = (qq >> 1) & 1;
          LAS unsigned char* vb = lds + AT_VOFF + (32 * qi + 4 * hi + qq) * AT_VSTR + (2 * dsub + (pp >> 1)) * 16 + 8 * (pp & 1);
          vp0 = vb + 64 * sw; vp1 = vb + 64 * (1 - sw); }
        const f32x16 cinit = {0.f, 0.f, 0.f, 0.f, 0.f, 0.f, 0.f, 0.f, 0.f, 0.f, 0.f, 0.f, 0.f, 0.f, 0.f, 0.f};
        const float Apos = slope2 * tq0 - mref2, Aneg = -slope2 * tq0 - mref2;
        bf16x8 kf[4];
#define AT_LOADK(t) do { _Pragma("unroll") for (int ks = 0; ks < 4; ++ks) kf[ks] = *(const LAS bf16x8*)(kp + (t) * (32 * AT_KSTR) + 32 * ks); } while (0)
#define AT_QK(p) do { p = __builtin_amdgcn_mfma_f32_32x32x16_bf16(kf[0], qf[0], cinit, 0, 0, 0); p = __builtin_amdgcn_mfma_f32_32x32x16_bf16(kf[1], qf[1], p, 0, 0, 0); \
                      p = __builtin_amdgcn_mfma_f32_32x32x16_bf16(kf[2], qf[2], p, 0, 0, 0); p = __builtin_amdgcn_mfma_f32_32x32x16_bf16(kf[3], qf[3], p, 0, 0, 0); } while (0)
        f32x16 pc; AT_LOADK(0); AT_QK(pc); AT_LOADK(1);
#pragma unroll
        for (int t = 0; t < ((AVAR & 4) ? 0 : 9); ++t) { const int D = t - 4;
            u32x4 va[2][2];
#pragma unroll
            for (int s = 0; s < 2; ++s)
#pragma unroll
                for (int dh = 0; dh < 2; ++dh) { LAS unsigned char* vpp = (dh ? vp1 : vp0) + (32 * t + 16 * s) * AT_VSTR;
                    const u32x2 lo = __builtin_bit_cast(u32x2, __builtin_amdgcn_ds_read_tr16_b64_v4i16((LAS v4i16_t*)vpp)), hi2 = __builtin_bit_cast(u32x2, __builtin_amdgcn_ds_read_tr16_b64_v4i16((LAS v4i16_t*)(vpp + 8 * AT_VSTR)));
                    va[s][dh] = u32x4{lo.x, lo.y, hi2.x, hi2.y}; }
            f32x16 pn;
            if (t + 1 < 9) { AT_QK(pn); if (t + 2 < 9) AT_LOADK(t + 2); }
            if (t == 5) {
#pragma unroll
                for (int rg = 0; rg < 4; ++rg)
#pragma unroll
                    for (int dt = 0; dt < 2; ++dt) zpre[2 * rg + dt] = *(const GAS u32x2*)(PO + qrow * OD_N + 1536 + 64 * hh + 32 * dt + 8 * rg + 4 * hi); }
            if (t == 7) {
                if (it == 0) { const int item1 = wid + 8, g1 = item1 >> 2, hh1 = 4 * kvh + g1;
#pragma unroll
                    for (int ks = 0; ks < 4; ++ks) qraw[ks] = *(const GAS u32x4*)(PO + qrow * OD_N + 64 * hh1 + 16 * ks + 8 * hi); } }
            float ps = 0.f;
#pragma unroll
            for (int r = 0; r < 16; ++r) { const int cr = (r & 3) + 8 * (r >> 2); const float c = (float)(32 * D + cr);
                float e;
                if (D > 0) e = __builtin_amdgcn_exp2f(__builtin_fmaf(slope2, -c, pc[r] + Apos));
                else if (D < 0) e = __builtin_amdgcn_exp2f(__builtin_fmaf(slope2, c, pc[r] + Aneg));
                else e = __builtin_amdgcn_exp2f(__builtin_fmaf(-slope2, fabsf(tq0 - c), pc[r]) - mref2);
                if (D == -4) e = (float)cr >= tq0 ? e : 0.f;
                if (D == 4) e = (float)cr <= tq0 ? e : 0.f;
                pc[r] = e; ps += e; }
            { const int kbt = (qi + t) >> 2; const float vm = kbt == 0 ? v0f : (kbt == 2 ? v2f : 1.0f); lpart += ps * vm; }
#pragma unroll
            for (int s = 0; s < 2; ++s) { float w[8];
#pragma unroll
                for (int e = 0; e < 8; ++e) w[e] = pc[8 * s + e];
                const bf16x8 pf = __builtin_bit_cast(bf16x8, pack8(w));
                o0 = __builtin_amdgcn_mfma_f32_32x32x16_bf16(__builtin_bit_cast(bf16x8, va[s][0]), pf, o0, 0, 0, 0);
                o1 = __builtin_amdgcn_mfma_f32_32x32x16_bf16(__builtin_bit_cast(bf16x8, va[s][1]), pf, o1, 0, 0, 0); }
            if (t + 1 < 9) pc = pn;
            asm volatile("" : "+v"(o0), "+v"(o1));
            __builtin_amdgcn_sched_barrier(0);
        }
#undef AT_LOADK
#undef AT_QK
        const float ltot = lpart + __shfl_xor(lpart, 32) + __builtin_amdgcn_exp2f(sinkv * LOG2E - mref2); const float inv = 1.0f / ltot;
#pragma unroll
        for (int rg = 0; rg < 4; ++rg) {
#pragma unroll
            for (int dt = 0; dt < 2; ++dt) { const int d0 = 32 * dt + 8 * rg + 4 * hi;
                const u32x2 zw = zpre[2 * rg + dt];
                const float z0 = bflo(zw.x), z1 = bfhi(zw.x), z2 = bflo(zw.y), z3 = bfhi(zw.y);
                const float v0 = (dt == 0 ? o0[4 * rg + 0] : o1[4 * rg + 0]) * inv * siluf_(z0), v1 = (dt == 0 ? o0[4 * rg + 1] : o1[4 * rg + 1]) * inv * siluf_(z1);
                const float v2 = (dt == 0 ? o0[4 * rg + 2] : o1[4 * rg + 2]) * inv * siluf_(z2), v3 = (dt == 0 ? o0[4 * rg + 3] : o1[4 * rg + 3]) * inv * siluf_(z3);
                u32x2 w; w.x = pk2(v0, v1); w.y = pk2(v2, v3); *(GAS u32x2*)(MIX + qrow * 1024 + 64 * hh + d0) = w; } }
    }
    lds_barrier();
}

#define PH_PROLOG KArgs a = opaque(a0); unsigned char* ws = a->ws; int tid_ = wave_s * 64 + lane_id(); asm volatile("" : "+v"(tid_)); int bx_ = blockIdx.x; asm volatile("" : "+s"(bx_)); \
    const int tid = tid_, lane = tid & 63, wave = __builtin_amdgcn_readfirstlane(tid >> 6); \
    const int G = gridDim.x, bx = bx_, gw = bx * NWAVES + wave, NGW = G * NWAVES; const int j = layer >> 1; (void)ws; (void)lane; (void)gw; (void)NGW; (void)j; (void)tid; \
    const float* xb0 = layer == 0 ? a->in[I_XP] : a->out; const float* xb1 = layer == 0 ? a->in[I_XS] : a->out + (size_t)TP * DM; (void)xb0; (void)xb1;
#define WSP(off) ((bf16_t*)(ws + (off)))

__device__ __forceinline__ void ph_even_prep(KArgs a0, LAS unsigned char* lds, int layer, int wave_s) { PH_PROLOG
    LAS float* scr = (LAS float*)(lds + wave * 16384);
    const float* win = a->in[I_EVWIN] + (size_t)j * DM * 3200; const float* wout = a->in[I_EVWOUT] + (size_t)j * DM * DM; const float* wglu = a->in[I_S5GLUW] + (size_t)j * 512 * 512;
    bf16_t* WIN = WSP(WS_WIN);
    constexpr int I1 = 16 * 100, I2 = 16 * 32, I3 = 8 * 16;
    const bool pre = layer != 0 && G == 256;
    const bool split = layer != 0 && G >= 256 && !pre;
    const int tgw = split ? (bx - 128) * NWAVES + wave : gw, tng = split ? (G - 128) * NWAVES : NGW, tbx = split ? bx - 128 : bx, tG = split ? G - 128 : G;
    if (!split || bx >= 128) {
    for (int it = tgw; it < I1 + I2 + I3; it += tng) { int r = it;
        if (r < I1) { transpose_item(win, DM, 3200, WIN, scr, r, lane, a->in[I_EVNORM] + j * DM); continue; } r -= I1;
        if (r < I2) { transpose_item(wout, DM, DM, WSP(WS_WOUT), scr, r, lane); continue; } r -= I2;
        transpose_item(wglu, 512, 512, WSP(WS_WGLU), scr, r, lane); }
    { unsigned z = 0u; asm volatile("" : "+v"(z));
      for (int e = tbx * 512 + tid; e < 128 * 1024 / 8; e += tG * 512) *(GAS u32x4*)(WIN + (size_t)3200 * DM + (size_t)e * 8) = (u32x4){z, z, z, z}; }
    { bf16_t* lo = WSP(WS_LORA); const float* aup = a->in[I_RWAUP] + (size_t)j * 64 * 512; const float* wup = a->in[I_RWWUP] + (size_t)j * 2 * 64 * 512;
      for (int e = tbx * 512 + tid; e < 3 * 512 * 64; e += tG * 512) { const int which = e >> 15, hc = (e >> 6) & 511, i = e & 63;
          lo[e] = (bf16_t)f2bf(which == 0 ? aup[(size_t)i * 512 + hc] : wup[((size_t)(which - 1) * 64 + i) * 512 + hc]); } }
    }
    __syncthreads();
    const bool spread = G >= 256;
    if (!pre && (spread ? bx < 128 : bx < 32)) s5_prep_group(a, j, spread ? bx >> 2 : bx, spread ? bx & 3 : 0, lds, WSP(WS_BMAT), WSP(WS_W2), tid);
    if (!spread && bx < 32) { s5_prep_group(a, j, bx, 1, lds, WSP(WS_BMAT), WSP(WS_W2), tid); s5_prep_group(a, j, bx, 2, lds, WSP(WS_BMAT), WSP(WS_W2), tid); s5_prep_group(a, j, bx, 3, lds, WSP(WS_BMAT), WSP(WS_W2), tid); }
    float* RSTD = (float*)(ws + WS_RSTD);
    if (layer != 0) { if (!split || bx >= 128) rstd_from_ssq((const float*)(ws + WS_SSQ), RSTD, tbx * 512 + tid, tG * 512); return; }
    constexpr int R1 = 15360;
    bf16_t* XR = (bf16_t*)a->out;
    int m0, m1, w0, wn;
    if (spread) { if (bx < 128) { m0 = 0; m1 = R1; w0 = bx * NWAVES + wave; wn = 128 * NWAVES; } else { m0 = R1; m1 = T; w0 = (bx - 128) * NWAVES + wave; wn = (G - 128) * NWAVES; } }
    else { m0 = 0; m1 = T; w0 = gw; wn = NGW; }
    for (int m = m0 + 2 * w0; m < m1; m += 2 * wn) raw_rows2_to_bf16(m < TP ? xb0 + (size_t)m * DM : xb1 + (size_t)(m - TP) * DM, m + 1 < TP ? xb0 + (size_t)(m + 1) * DM : xb1 + (size_t)(m + 1 - TP) * DM, XR + (size_t)m * DM, XR + (size_t)(m + 1) * DM, RSTD + m, RSTD + m + 1, lane);
}
__device__ __forceinline__ void ph_even_inproj(KArgs a0, LAS unsigned char* lds, int layer, int wave_s) { PH_PROLOG
    pg8::Gemm g{(const bf16_t*)a->out, WSP(WS_WIN), DM, DM, DM}; pg8::StaticOrder S; S.init(T, EV_N, G, bx); pg8::EpiEvenIn E{WSP(WS_UH), WSP(WS_ZS5), WSP(WS_PRW), (const float*)(ws + WS_RSTD)}; pg8::gemm_phase(lds, g, S, E, tid);
}
__device__ __forceinline__ void ph_s5_hend(KArgs a0, LAS unsigned char* lds, int layer, int wave_s) { PH_PROLOG
    pg8::Gemm g{WSP(WS_UH), WSP(WS_BMAT), 256, 512, 256}; pg8::GroupedOrder S; S.init(32 * NINST / 256, NINST / 256, G, bx); pg8::EpiBf16 E{WSP(WS_A), 256}; pg8::gemm_phase(lds, g, S, E, tid);
}
__device__ __forceinline__ void ph_s5_carry_a(KArgs a0, LAS unsigned char* lds, int layer, int wave_s) { PH_PROLOG
    for (int u = gw; u < 96 * 64; u += NGW) s5_carry_seg<false>(a, j, u, WSP(WS_A), (float*)(ws + WS_A + 48 * MiB), WSP(WS_UH), lane);
    for (int u = gw; u < SH_NSEG * 2; u += NGW) shift_save_halo(WSP(WS_PRW), WSP(WS_BMAT), u, lane);
}
__device__ __forceinline__ void ph_s5_carry_b(KArgs a0, LAS unsigned char* lds, int layer, int wave_s) { PH_PROLOG
    for (int u = gw; u < 96 * 64; u += NGW) s5_carry_seg<true>(a, j, u, WSP(WS_A), (float*)(ws + WS_A + 48 * MiB), WSP(WS_UH), lane);
    for (int u = gw; u < SH_NSEG * 4; u += NGW) shift_rows(a, j, WSP(WS_PRW), WSP(WS_BMAT), u, lane);
}
__device__ __forceinline__ void ph_s5_out(KArgs a0, LAS unsigned char* lds, int layer, int wave_s) { PH_PROLOG
    pg8::Gemm g{WSP(WS_UH), WSP(WS_W2), 512, 512, 512}; pg8::GroupedOrder S; S.init(32 * NINST / 256, NINST / 256, G, bx); pg8::EpiS5Out E{WSP(WS_A + 48 * MiB)}; pg8::gemm_phase(lds, g, S, E, tid);
    if (G == 256 && bx >= 128) { LAS float* scr = (LAS float*)(lds + wave * 16384);
        const float* win = a->in[I_ODWIN] + (size_t)j * DM * OD_N; const float* wout = a->in[I_ODWOUT] + (size_t)j * DM * DM; constexpr int I1 = 16 * 80, I2 = 16 * 32;
        for (int it = (bx - 128) * NWAVES + wave; it < I1 + I2; it += 128 * NWAVES) { if (it < I1) transpose_item(win, DM, OD_N, WSP(WS_WIN), scr, it, lane, a->in[I_ODNORM] + j * DM); else transpose_item(wout, DM, DM, WSP(WS_WOUT2), scr, it - I1, lane); } }
}
__device__ __forceinline__ void ph_glu(KArgs a0, LAS unsigned char* lds, int layer, int wave_s) { PH_PROLOG
    pg8::Gemm g{WSP(WS_A + 48 * MiB), WSP(WS_WGLU), 512, 512, 512}; pg8::StaticOrder S; S.init(T, 512, G, bx);
    pg8::EpiGlu E{WSP(WS_A + 48 * MiB), WSP(WS_ZS5), a->in[I_S5GLUB] + j * 512, WSP(WS_UH)}; pg8::gemm_phase(lds, g, S, E, tid);
}
__device__ __forceinline__ void ph_rwkv_p1(KArgs a0, LAS unsigned char* lds, int layer, int wave_s) { PH_PROLOG
    if (wave >= 4) __builtin_amdgcn_s_setprio(1);
    for (int it = bx; it < rw::NSC * 8; it += G) rw::unit_pair<true, 0, true>(a, j, it, lds, WSP(WS_PRW), WSP(WS_LORA), (float*)(ws + WS_PS), (float*)(ws + WS_RWH), WSP(WS_A), WSP(WS_YB), nullptr, nullptr, tid, WSP(WS_E), WSP(WS_E + 48 * MiB), (float*)(ws + WS_BS));
    __builtin_amdgcn_s_setprio(0);
}
#ifdef PROBE_V
__device__ __forceinline__ void ph_rwkv_probe(KArgs a0, LAS unsigned char* lds, int layer, int wave_s) { PH_PROLOG
    for (int it = bx; it < rw::NSC * 8; it += G) rw::unit_pair<false, PROBE_V>(a, j, it, lds, WSP(WS_PRW), WSP(WS_LORA), (float*)(ws + WS_A), (float*)(ws + WS_RWH), nullptr, nullptr, nullptr, nullptr, tid);
}
#endif
__device__ __forceinline__ void ph_rwkv_p2(KArgs a0, LAS unsigned char* lds, int layer, int wave_s) { PH_PROLOG
    const bool split = G == 256;
    if (bx < 80) for (int c = bx; c < 80; c += G) rw::chain_states(c, lds, (const float*)(ws + WS_PS), (float*)(ws + WS_RWH), tid);
    pg8::Gemm g{WSP(WS_A + 48 * MiB), WSP(WS_WGLU), 512, 512, 512}; pg8::SpanOrder S; S.init(T, 512, G, bx);
    if (!split) { S.base = bx; S.stride = G; S.cnt = (384 - bx + G - 1) / G; }
    else if (bx >= 80) { S.base = bx - 80; S.stride = 176; S.cnt = 2; }
    else { S.base = 352 + (bx - 16); S.stride = 0; S.cnt = (bx >= 16 && bx < 48) ? 1 : 0; }
    pg8::EpiGlu E{WSP(WS_A + 48 * MiB), WSP(WS_ZS5), a->in[I_S5GLUB] + j * 512, WSP(WS_UH)}; pg8::gemm_phase(lds, g, S, E, tid);
}
__device__ __forceinline__ void ph_rwkv_p3(KArgs a0, LAS unsigned char* lds, int layer, int wave_s) { PH_PROLOG
    if (wave >= 4) __builtin_amdgcn_s_setprio(1);
    for (int it = bx; it < rw::NSC * 8; it += G) rw::fix_unit(a, j, it, lds, WSP(WS_PRW), (const float*)(ws + WS_RWH), WSP(WS_A), WSP(WS_YB), WSP(WS_E), WSP(WS_E + 48 * MiB), (const float*)(ws + WS_BS), WSP(WS_UH), tid);
    __builtin_amdgcn_s_setprio(0);
}
__device__ __forceinline__ void ph_outproj(KArgs a0, LAS unsigned char* lds, int layer, int wave_s, size_t mix_off) { PH_PROLOG
    pg8::Gemm g{WSP(mix_off), WSP((layer & 1) && G == 256 ? WS_WOUT2 : WS_WOUT), DM, DM, DM}; pg8::StaticOrder S; S.init(T, DM, G, bx); bf16_t* XO = (bf16_t*)a->out;
    pg8::EpiRes E{layer == 0 ? a->in[I_XP] : (const float*)nullptr, a->in[I_XS], (layer & 1) ? WSP(WS_A) : XO, layer == 3 ? a->out : (float*)nullptr, (layer & 1) ? XO : WSP(WS_A), (float*)(ws + WS_SSQ)}; pg8::gemm_phase(lds, g, S, E, tid);
}
__device__ __forceinline__ void ph_odd_prep(KArgs a0, LAS unsigned char* lds, int layer, int wave_s) { PH_PROLOG
    LAS float* scr = (LAS float*)(lds + wave * 16384);
    const float* win = a->in[I_ODWIN] + (size_t)j * DM * OD_N; const float* wout = a->in[I_ODWOUT] + (size_t)j * DM * DM;
    constexpr int I1 = 16 * 80, I2 = 16 * 32;
    if (G != 256)
    for (int it = gw; it < I1 + I2; it += NGW) { int r = it;
        if (r < I1) { transpose_item(win, DM, OD_N, WSP(WS_WIN), scr, r, lane, a->in[I_ODNORM] + j * DM); continue; } r -= I1;
        transpose_item(wout, DM, DM, WSP(WS_WOUT), scr, r, lane); }
    rstd_from_ssq((const float*)(ws + WS_SSQ), (float*)(ws + WS_RSTD), bx * 512 + tid, G * 512);
}
__device__ __forceinline__ void ph_odd_inproj(KArgs a0, LAS unsigned char* lds, int layer, int wave_s) { PH_PROLOG
    pg8::Gemm g{WSP(WS_A), WSP(WS_WIN), DM, DM, DM}; pg8::StaticOrder S; S.init(T, OD_N, G, bx); pg8::EpiBf16S E; E.O = WSP(WS_UH); E.ldc = OD_N; E.rs = (const float*)(ws + WS_RSTD); pg8::gemm_phase(lds, g, S, E, tid);
    if (layer == 1 && G == 256 && bx >= 128) s5_prep_group(a, 1, (bx - 128) >> 2, (bx - 128) & 3, lds, WSP(WS_BMAT), WSP(WS_W2), tid);
}
#ifdef PROBE_A
__device__ __forceinline__ void ph_attn_probe(KArgs a0, LAS unsigned char* lds, int layer, int wave_s) { PH_PROLOG
    const float mref2 = attn_mref2(a, j);
    for (int u = bx; u < (T / 128) * 4; u += G) attn_unit<PROBE_A>(a, j, u, lds, WSP(WS_UH), WSP(WS_MIXO), tid, mref2);
}
#endif
__device__ __forceinline__ void ph_attn(KArgs a0, LAS unsigned char* lds, int layer, int wave_s) { PH_PROLOG
    if (wave >= 4) __builtin_amdgcn_s_setprio(1);
    const float mref2 = attn_mref2(a, j);
    for (int u = bx; u < (T / 128) * 4; u += G) attn_unit(a, j, u, lds, WSP(WS_UH), WSP(WS_MIXO), tid, mref2);
    __builtin_amdgcn_s_setprio(0);
}

__global__ void __launch_bounds__(NWAVES * 64, 2) trunk_fwd(Args args) {
    extern __shared__ __attribute__((aligned(16))) unsigned char lds_raw[];
    LAS unsigned char* lds = (LAS unsigned char*)lds_raw;
    KArgs a0 = (KArgs)__builtin_amdgcn_kernarg_segment_ptr();
    const int wave_s = __builtin_amdgcn_readfirstlane((int)threadIdx.x >> 6);
    for (int u = wave_s * 64 + lane_id(); u < (LDS_BYTES - LDSCTL_OFF) / 4; u += NWAVES * 64) ((LAS unsigned*)(lds + LDSCTL_OFF))[u] = 0u;
    __syncthreads();
    (void)xcd_barrier_post((unsigned*)(a0->ws + WS_CTL) + CW_BAR, (volatile LAS unsigned*)(lds + MISC_OFF) + 8, wave_s == 0 && lane_id() == 0);
    const int ph_lo = a0->ph_lo, ph_hi = a0->ph_hi;
    int ph = 0;
#ifndef DUPM
#define DUPM 0u
#endif
#define GRID_BAR() do { KArgs ab = opaque(a0); XcdBarrier bar_; bar_.bar = (unsigned*)(ab->ws + WS_CTL) + CW_BAR; bar_.x = xb_xcc_id(); bar_.st = (volatile LAS unsigned*)(lds + MISC_OFF) + 8; xcd_barrier(bar_, wave_s); } while (0)
#define RUN_PHASE(call) do { if (ph >= ph_lo && ph < ph_hi) { call; if ((DUPM >> kind) & 1u) { GRID_BAR(); call; } if (ph + 1 < ph_hi) GRID_BAR(); } ++ph; ++kind; } while (0)
#define EVEN_LAYER(L) do { const int layer = (L); int kind = 0; (void)kind; \
            RUN_PHASE(ph_even_prep(a0, lds, layer, wave_s)); \
            RUN_PHASE(ph_even_inproj(a0, lds, layer, wave_s)); \
            RUN_PHASE(ph_s5_hend(a0, lds, layer, wave_s)); \
            RUN_PHASE(ph_s5_carry_a(a0, lds, layer, wave_s)); \
            RUN_PHASE(ph_s5_carry_b(a0, lds, layer, wave_s)); \
            RUN_PHASE(ph_s5_out(a0, lds, layer, wave_s)); \
            RUN_PHASE(ph_rwkv_p1(a0, lds, layer, wave_s)); \
            RUN_PHASE(ph_rwkv_p2(a0, lds, layer, wave_s)); \
            RUN_PHASE(ph_rwkv_p3(a0, lds, layer, wave_s)); \
            RUN_PHASE(ph_outproj(a0, lds, layer, wave_s, WS_UH)); } while (0)
#ifdef PROBE_A
#define ATTN_PROBE() do { ph_attn_probe(a0, lds, layer, wave_s); GRID_BAR(); } while (0)
#else
#define ATTN_PROBE() do {} while (0)
#endif
#define ODD_LAYER(L) do { const int layer = (L); int kind = 10; (void)kind; \
            RUN_PHASE(ph_odd_prep(a0, lds, layer, wave_s)); \
            RUN_PHASE(ph_odd_inproj(a0, lds, layer, wave_s)); \
            ATTN_PROBE(); RUN_PHASE(ph_attn(a0, lds, layer, wave_s)); \
            RUN_PHASE(ph_outproj(a0, lds, layer, wave_s, WS_MIXO)); } while (0)
    EVEN_LAYER(0); ODD_LAYER(1); EVEN_LAYER(2); ODD_LAYER(3);
#undef EVEN_LAYER
#undef ODD_LAYER
#undef RUN_PHASE
}
constexpr int N_PHASES = 28;

extern "C" void kernel_launch(void* const* d_in, const int* in_sizes, int n_in, void* d_out, int out_size, void* d_ws, size_t ws_size, hipStream_t stream) {
    static int grid = 0;
    if (grid == 0) {
        if (n_in != 31 || out_size != T * DM || ws_size < WS_END) { fprintf(stderr, "kernel_launch: unexpected problem: n_in %d out %d ws %zu (need %zu)\n", n_in, out_size, ws_size, (size_t)WS_END); grid = -1; return; }
        int dev = 0, cus = 0, per_cu = 0;
        if (hipGetDevice(&dev) != hipSuccess || hipDeviceGetAttribute(&cus, hipDeviceAttributeMultiprocessorCount, dev) != hipSuccess) { grid = -1; return; }
        if (hipFuncSetAttribute((const void*)trunk_fwd, hipFuncAttributeMaxDynamicSharedMemorySize, LDS_BYTES) != hipSuccess) { fprintf(stderr, "kernel_launch: hipFuncSetAttribute failed\n"); grid = -1; return; }
        if (hipOccupancyMaxActiveBlocksPerMultiprocessor(&per_cu, (const void*)trunk_fwd, NWAVES * 64, LDS_BYTES) != hipSuccess || per_cu < 1) { fprintf(stderr, "kernel_launch: occupancy query says %d blocks per CU\n", per_cu); (void)hipGetLastError(); grid = -1; return; }
        grid = cus;
    }
    if (grid < 0) return;
    if (hipMemsetAsync((char*)d_ws + WS_CTL, 0, CTL_ZERO_BYTES, stream) != hipSuccess) return;
    Args a{};
    for (int i = 0; i < 31; ++i) a.in[i] = (const float*)d_in[i];
    a.out = (float*)d_out; a.ws = (unsigned char*)d_ws; a.ph_lo = 0; a.ph_hi = N_PHASES;
    hipLaunchKernelGGL(trunk_fwd, dim3(grid), dim3(NWAVES * 64), LDS_BYTES, stream, a);
}
```
